# Optimizing an MI355X kernel written in HIP

```python
import math
import jax, jax.numpy as jnp
from jax import lax
import numpy as np

D_MODEL = 2048
BATCH = 8
SEQ = 4096
DEPTH = 2

MLA_HEADS = 8
MLA_Q_RANK = 512
MLA_KV_RANK = 512
MLA_NOPE = 128
MLA_ROPE = 64
MLA_V = 128
ROPE_THETA = 10000.0
ML_HEADS = 4
ML_QK = 128
ML_V = 256
ML_CHUNK = 64
ML_F_BIAS_LO = 3.0
ML_F_BIAS_HI = 6.0
DA_HEADS = 8
DA_HEAD = 128
D_FF = 5632
Q_BLOCK = 128
EPS = 1e-6
NEG_INIT = -1e30

EVEN_SPLITS = (MLA_Q_RANK, MLA_KV_RANK, MLA_ROPE, ML_HEADS * ML_QK, ML_HEADS * ML_QK, ML_HEADS * ML_V, ML_HEADS * ML_V, 4 * ML_HEADS)
EVEN_IN = sum(EVEN_SPLITS)
EVEN_OUT = MLA_HEADS * MLA_V + ML_HEADS * ML_V
ODD_IN = 3 * DA_HEADS * 2 * DA_HEAD
ODD_OUT = DA_HEADS * 2 * DA_HEAD

kernel_name = "hybrid_mla_mlstm_diffattn_macaron_encoder"


def rmsnorm(x, g):
    xf = x.astype(jnp.float32)
    y = xf * lax.rsqrt(jnp.mean(xf * xf, axis=-1, keepdims=True) + EPS)
    return (y * g.astype(jnp.float32)).astype(x.dtype)


def swiglu(x, w_gu, w_down):
    gate, up = jnp.split(x @ w_gu, 2, axis=-1)
    return (jax.nn.silu(gate) * up) @ w_down


def rotate(x, cos, sin):
    x1, x2 = jnp.split(x, 2, axis=-1)
    return jnp.concatenate([x1 * cos - x2 * sin, x2 * cos + x1 * sin], axis=-1)


def split_cols(z, sizes):
    idx = np.cumsum(sizes)[:-1].tolist()
    return jnp.split(z, idx, axis=-1)


def alibi_slopes(n):
    return jnp.asarray([2.0 ** (-8.0 * (h + 1) / n) for h in range(n)], dtype=jnp.float32)


def to_query_blocks(t):
    b, h, s, d = t.shape
    return jnp.moveaxis(t.reshape(b, h, s // Q_BLOCK, Q_BLOCK, d), 2, 0)


def from_query_blocks(o):
    nb, b, h, q, d = o.shape
    return jnp.moveaxis(o, 0, 2).reshape(b, h, nb * q, d)


def mla_attention(q, k, v):
    q = q * (q.shape[-1] ** -0.5)

    def block(qi):
        s = jnp.einsum('bhqd,bhkd->bhqk', qi, k).astype(jnp.float32)
        p = jax.nn.softmax(s, axis=-1).astype(v.dtype)
        return jnp.einsum('bhqk,bhkd->bhqd', p, v)

    return from_query_blocks(lax.map(block, to_query_blocks(q)))


def mlstm_direction(q, k, v, log_i, log_f):
    b, h, s, _ = q.shape
    dk, dv = q.shape[-1], v.shape[-1]
    nc, L = s // ML_CHUNK, ML_CHUNK

    def to_chunks(t):
        return jnp.moveaxis(t.reshape(t.shape[:2] + (nc, L) + t.shape[3:]), 2, 0)

    lower = jnp.tril(jnp.ones((L, L), dtype=bool))

    def step(carry, inp):
        c_st, n_st, m_st = carry
        qc, kc, vc, li, lf = inp
        a = jnp.cumsum(lf, axis=-1)
        g = a[..., -1]
        dmat = jnp.where(lower, a[..., :, None] - a[..., None, :] + li[..., None, :], -jnp.inf)
        inter = a + m_st[..., None]
        m = jnp.maximum(inter, jnp.max(dmat, axis=-1))
        w_inter = jnp.exp(inter - m)
        qk = jnp.einsum('bhld,bhsd->bhls', qc, kc) * jnp.exp(dmat - m[..., None])
        num = w_inter[..., None] * jnp.einsum('bhld,bhde->bhle', qc, c_st) + jnp.einsum('bhls,bhse->bhle', qk, vc)
        den = w_inter * jnp.einsum('bhld,bhd->bhl', qc, n_st) + jnp.sum(qk, axis=-1)
        h_out = num / jnp.maximum(jnp.abs(den), jnp.exp(-m))[..., None]
        r = g[..., None] - a + li
        m_new = jnp.maximum(g + m_st, jnp.max(r, axis=-1))
        w_old = jnp.exp(g + m_st - m_new)
        w_r = jnp.exp(r - m_new[..., None])
        c_new = w_old[..., None, None] * c_st + jnp.einsum('bhs,bhsd,bhse->bhde', w_r, kc, vc)
        n_new = w_old[..., None] * n_st + jnp.einsum('bhs,bhsd->bhd', w_r, kc)
        return (c_new, n_new, m_new), h_out

    init = (jnp.zeros((b, h, dk, dv), jnp.float32), jnp.zeros((b, h, dk), jnp.float32),
            jnp.full((b, h), NEG_INIT, jnp.float32))
    _, hs = lax.scan(step, init, (to_chunks(q), to_chunks(k), to_chunks(v), to_chunks(log_i), to_chunks(log_f)))
    return jnp.moveaxis(hs, 0, 2).reshape(b, h, s, dv)


def mlstm_bidirectional(q, k, v, li_f, lf_f, li_b, lf_b):
    flip = lambda t: jnp.flip(t, axis=2)
    h_f = mlstm_direction(q, k, v, li_f, lf_f)
    h_b = flip(mlstm_direction(flip(q), flip(k), flip(v), flip(li_b), flip(lf_b)))
    return h_f + h_b


def even_mixer(h, cos, sin, w_in, g_cq, w_uq, g_ckv, w_ukv, b_gates, g_mlstm, w_o):
    b, s, _ = h.shape
    c_q, c_kv, k_r, m_q, m_k, m_v, m_o, m_g = split_cols(h @ w_in, EVEN_SPLITS)
    q = (rmsnorm(c_q, g_cq) @ w_uq).reshape(b, s, MLA_HEADS, MLA_NOPE + MLA_ROPE)
    kv = (rmsnorm(c_kv, g_ckv) @ w_ukv).reshape(b, s, MLA_HEADS, MLA_NOPE + MLA_V)
    q = jnp.concatenate([q[..., :MLA_NOPE], rotate(q[..., MLA_NOPE:], cos[:, :, None, :], sin[:, :, None, :])], axis=-1)
    k_rope = jnp.broadcast_to(rotate(k_r, cos, sin)[:, :, None, :], (b, s, MLA_HEADS, MLA_ROPE))
    k = jnp.concatenate([kv[..., :MLA_NOPE], k_rope], axis=-1)
    v = kv[..., MLA_NOPE:]
    a_out = mla_attention(q.transpose(0, 2, 1, 3), k.transpose(0, 2, 1, 3), v.transpose(0, 2, 1, 3))
    a_out = a_out.transpose(0, 2, 1, 3).reshape(b, s, MLA_HEADS * MLA_V)
    heads = lambda t, d: t.reshape(b, s, ML_HEADS, d).transpose(0, 2, 1, 3).astype(jnp.float32)
    mq = heads(m_q, ML_QK)
    mk = heads(m_k, ML_QK) * (ML_QK ** -0.5)
    mv = heads(m_v, ML_V)
    gates = (m_g + b_gates).astype(jnp.float32).reshape(b, s, 4, ML_HEADS).transpose(2, 0, 3, 1)
    hm = mlstm_bidirectional(mq, mk, mv, gates[0], jax.nn.log_sigmoid(gates[1]), gates[2], jax.nn.log_sigmoid(gates[3]))
    hm = hm * lax.rsqrt(jnp.mean(hm * hm, axis=-1, keepdims=True) + EPS) * g_mlstm.astype(jnp.float32).reshape(ML_HEADS, 1, ML_V)
    m_out = hm.transpose(0, 2, 1, 3).reshape(b, s, ML_HEADS * ML_V).astype(h.dtype) * jax.nn.sigmoid(m_o)
    return jnp.concatenate([a_out, m_out], axis=-1) @ w_o


def diff_attention(q1, q2, k1, k2, v, positions, lam):
    slopes = alibi_slopes(DA_HEADS)
    nb = positions.shape[1] // Q_BLOCK
    pb = jnp.moveaxis(positions.reshape(positions.shape[0], nb, Q_BLOCK), 1, 0)

    def block(args):
        q1i, q2i, pi = args
        dist = jnp.abs(pi[:, :, None] - positions[:, None, :]).astype(jnp.float32)
        bias = -slopes[None, :, None, None] * dist[:, None, :, :]
        s1 = jnp.einsum('bhqd,bhkd->bhqk', q1i, k1).astype(jnp.float32) + bias
        s2 = jnp.einsum('bhqd,bhkd->bhqk', q2i, k2).astype(jnp.float32) + bias
        a = jax.nn.softmax(s1, axis=-1) - lam * jax.nn.softmax(s2, axis=-1)
        return jnp.einsum('bhqk,bhkd->bhqd', a.astype(v.dtype), v)

    return from_query_blocks(lax.map(block, (to_query_blocks(q1), to_query_blocks(q2), pb)))


def odd_mixer(h, positions, w_in, lam_q1, lam_k1, lam_q2, lam_k2, g_sub, w_o, lam_init):
    b, s, _ = h.shape
    q, k, v = jnp.split(h @ w_in, 3, axis=-1)
    q = q.reshape(b, s, DA_HEADS, 2, DA_HEAD) * (DA_HEAD ** -0.5)
    k = k.reshape(b, s, DA_HEADS, 2, DA_HEAD)
    v = v.reshape(b, s, DA_HEADS, 2 * DA_HEAD).transpose(0, 2, 1, 3)
    q1, q2 = q[..., 0, :].transpose(0, 2, 1, 3), q[..., 1, :].transpose(0, 2, 1, 3)
    k1, k2 = k[..., 0, :].transpose(0, 2, 1, 3), k[..., 1, :].transpose(0, 2, 1, 3)
    f32 = jnp.float32
    lam = (jnp.exp(jnp.sum(lam_q1.astype(f32) * lam_k1.astype(f32)))
           - jnp.exp(jnp.sum(lam_q2.astype(f32) * lam_k2.astype(f32))) + lam_init)
    o = diff_attention(q1, q2, k1, k2, v, positions, lam)
    o = rmsnorm(o, g_sub) * (1.0 - lam_init)
    return o.transpose(0, 2, 1, 3).reshape(b, s, ODD_OUT) @ w_o


def setup_inputs(seed: int = 0) -> dict:
    key = jax.random.key(seed)
    ks = iter(jax.random.split(key, 64))
    f32 = jnp.float32

    def dense(fan_in, fan_out):
        return jax.random.normal(next(ks), (fan_in, fan_out), f32) * (fan_in ** -0.5)

    def gain(n):
        return 1.0 + 0.02 * jax.random.normal(next(ks), (n,), f32)

    def small(n, scale):
        return scale * jax.random.normal(next(ks), (n,), f32)

    x = jax.random.normal(next(ks), (BATCH, SEQ, D_MODEL), f32)
    offset = jax.random.randint(next(ks), (BATCH, 1), 0, SEQ, dtype=jnp.int32)
    positions = offset + jnp.arange(SEQ, dtype=jnp.int32)[None, :]
    f_bias = jnp.linspace(ML_F_BIAS_LO, ML_F_BIAS_HI, ML_HEADS, dtype=f32)
    b_gates = jnp.concatenate([small(ML_HEADS, 0.1), f_bias + small(ML_HEADS, 0.1),
                               small(ML_HEADS, 0.1), f_bias + small(ML_HEADS, 0.1)])
    return {
        "x": x,
        "positions": positions,
        "l0_ffn1_norm": gain(D_MODEL),
        "l0_ffn1_w_gu": dense(D_MODEL, 2 * D_FF),
        "l0_ffn1_w_down": dense(D_FF, D_MODEL),
        "l0_mix_norm": gain(D_MODEL),
        "l0_w_in": dense(D_MODEL, EVEN_IN),
        "l0_g_cq": gain(MLA_Q_RANK),
        "l0_w_uq": dense(MLA_Q_RANK, MLA_HEADS * (MLA_NOPE + MLA_ROPE)),
        "l0_g_ckv": gain(MLA_KV_RANK),
        "l0_w_ukv": dense(MLA_KV_RANK, MLA_HEADS * (MLA_NOPE + MLA_V)),
        "l0_b_gates": b_gates,
        "l0_g_mlstm": gain(ML_HEADS * ML_V),
        "l0_w_o": dense(EVEN_OUT, D_MODEL),
        "l0_ffn2_norm": gain(D_MODEL),
        "l0_ffn2_w_gu": dense(D_MODEL, 2 * D_FF),
        "l0_ffn2_w_down": dense(D_FF, D_MODEL),
        "l1_ffn1_norm": gain(D_MODEL),
        "l1_ffn1_w_gu": dense(D_MODEL, 2 * D_FF),
        "l1_ffn1_w_down": dense(D_FF, D_MODEL),
        "l1_mix_norm": gain(D_MODEL),
        "l1_w_in": dense(D_MODEL, ODD_IN),
        "l1_lam_q1": small(DA_HEAD, 0.1),
        "l1_lam_k1": small(DA_HEAD, 0.1),
        "l1_lam_q2": small(DA_HEAD, 0.1),
        "l1_lam_k2": small(DA_HEAD, 0.1),
        "l1_g_sub": gain(2 * DA_HEAD),
        "l1_w_o": dense(ODD_OUT, D_MODEL),
        "l1_ffn2_norm": gain(D_MODEL),
        "l1_ffn2_w_gu": dense(D_MODEL, 2 * D_FF),
        "l1_ffn2_w_down": dense(D_FF, D_MODEL),
        "final_norm": gain(D_MODEL),
    }


def reference(x, positions,
              l0_ffn1_norm, l0_ffn1_w_gu, l0_ffn1_w_down,
              l0_mix_norm, l0_w_in, l0_g_cq, l0_w_uq, l0_g_ckv, l0_w_ukv, l0_b_gates, l0_g_mlstm, l0_w_o,
              l0_ffn2_norm, l0_ffn2_w_gu, l0_ffn2_w_down,
              l1_ffn1_norm, l1_ffn1_w_gu, l1_ffn1_w_down,
              l1_mix_norm, l1_w_in, l1_lam_q1, l1_lam_k1, l1_lam_q2, l1_lam_k2, l1_g_sub, l1_w_o,
              l1_ffn2_norm, l1_ffn2_w_gu, l1_ffn2_w_down,
              final_norm):
    inv_freq = ROPE_THETA ** (-jnp.arange(0, MLA_ROPE, 2, dtype=jnp.float32) / MLA_ROPE)
    ang = positions.astype(jnp.float32)[..., None] * inv_freq
    cos, sin = jnp.cos(ang).astype(x.dtype), jnp.sin(ang).astype(x.dtype)

    ffn_params = [((l0_ffn1_norm, l0_ffn1_w_gu, l0_ffn1_w_down), (l0_ffn2_norm, l0_ffn2_w_gu, l0_ffn2_w_down)),
                  ((l1_ffn1_norm, l1_ffn1_w_gu, l1_ffn1_w_down), (l1_ffn2_norm, l1_ffn2_w_gu, l1_ffn2_w_down))]
    mix_norms = [l0_mix_norm, l1_mix_norm]
    even_params = [(l0_w_in, l0_g_cq, l0_w_uq, l0_g_ckv, l0_w_ukv, l0_b_gates, l0_g_mlstm, l0_w_o)]
    odd_params = [(l1_w_in, l1_lam_q1, l1_lam_k1, l1_lam_q2, l1_lam_k2, l1_g_sub, l1_w_o)]

    for layer in range(DEPTH):
        f1, f2 = ffn_params[layer]
        x = x + 0.5 * swiglu(rmsnorm(x, f1[0]), f1[1], f1[2])
        hn = rmsnorm(x, mix_norms[layer])
        if layer % 2 == 0:
            x = x + even_mixer(hn, cos, sin, *even_params[layer // 2])
        else:
            lam_init = 0.8 - 0.6 * math.exp(-0.3 * layer)
            x = x + odd_mixer(hn, positions, *odd_params[layer // 2], lam_init=lam_init)
        x = x + 0.5 * swiglu(rmsnorm(x, f2[0]), f2[1], f2[2])
    return rmsnorm(x, final_norm)
```

```cpp
#include <hip/hip_runtime.h>
#include <hip/hip_cooperative_groups.h>
#include <cstdio>
#include <cstdint>
#include <cmath>
namespace cg = cooperative_groups;
__device__ __forceinline__ int mk_lane() { int l; asm volatile("v_mbcnt_lo_u32_b32 %0, -1, 0\n\tv_mbcnt_hi_u32_b32 %0, -1, %0" : "=v"(l)); return l; }
#ifndef MK_N_LAUNCHES
#define MK_N_LAUNCHES 1
#endif
namespace pg8 {
#define PG8_LAS __attribute__((address_space(3)))
typedef unsigned short bf16_t;
typedef short bf16x8 __attribute__((ext_vector_type(8)));
typedef float f32x4 __attribute__((ext_vector_type(4)));
typedef unsigned u32x4 __attribute__((ext_vector_type(4)));
constexpr int BM = 256, BK = 64, HALF = 128, HTB = HALF * BK * 2  , STAGE_BYTES = 8 * HTB, NXCD = 8, WGM = 8;

__host__ __device__ __forceinline__ int lds_byte(int r, int c) { const int st = (r >> 4) * 2 + (c >> 5), rr = r & 15, cc = c & 31, ob = rr * 64 + cc * 2; return st * 1024 + (ob ^ (((ob >> 9) & 1) << 5)); }
__host__ __device__ __forceinline__ void stage_rc(int b, int& R, int& C) { const int st = b / 1024, sb = b % 1024, swz = sb ^ (((sb >> 9) & 1) << 5); R = (st >> 1) * 16 + swz / 64; C = (st & 1) * 32 + (swz % 64) / 2; }
__host__ __device__ __forceinline__ int perm32(int rho) { const int n = rho >> 4, i = rho & 15; return 8 * (i >> 2) + 4 * n + (i & 3); }

struct Unit { int pm, pn; };
struct Gemm { const bf16_t* A; const bf16_t* Bt; int M, N, K, lda; };

struct StaticOrder {
    int nM, nN, nwg, G, c;
    __host__ __device__ void init(int M, int N, int G_, int c_) { nM = M / BM; nN = N / BM; nwg = nM * nN; G = G_; c = c_; }
    __host__ __device__ bool next(int i, Unit& u) const {
        const long L = (long)i * G + c; if (L >= nwg) return false;
        int wgid = (int)L; { const int q = nwg / NXCD, r = nwg % NXCD, xcd = wgid % NXCD, off = wgid / NXCD; wgid = (xcd < r ? xcd * (q + 1) : r * (q + 1) + (xcd - r) * q) + off; }
        const int nig = WGM * nN, gid = wgid / nig, fm = gid * WGM, gsz = (nM - fm) < WGM ? (nM - fm) : WGM;
        u.pm = fm + ((wgid % nig) % gsz); u.pn = (wgid % nig) / gsz; return true;
    }
    __device__ __forceinline__ void a_ready(const Unit&) const {}
    __device__ __forceinline__ void done(const Unit&) const {}
};

typedef float f32x2_t __attribute__((ext_vector_type(2))); typedef __bf16 bf16x2_t __attribute__((ext_vector_type(2)));
__device__ __forceinline__ unsigned cvt_pk_bf16(float lo, float hi) { f32x2_t v = {lo, hi}; bf16x2_t b = __builtin_convertvector(v, bf16x2_t); return __builtin_bit_cast(unsigned, b); }
__device__ __forceinline__ u32x4 pack8(const f32x4 a, const f32x4 b) { u32x4 w; w.x = cvt_pk_bf16(a[0], a[1]); w.y = cvt_pk_bf16(a[2], a[3]); w.z = cvt_pk_bf16(b[0], b[1]); w.w = cvt_pk_bf16(b[2], b[3]); return w; }
typedef unsigned long long ssq_t;
__device__ __forceinline__ float rstd_of(ssq_t ss, float inv_n) { return __builtin_amdgcn_rsqf((float)ss * (1.0f / 16777216.0f) * inv_n + 1e-6f); }
__device__ __forceinline__ void ss_add(ssq_t* p, float sq) { __hip_atomic_fetch_add(p, (ssq_t)(sq * 16777216.0f), __ATOMIC_RELAXED, __HIP_MEMORY_SCOPE_AGENT); }
__device__ __forceinline__ float silu_mul(float g, float u) { return g * u * __builtin_amdgcn_rcpf(1.0f + __builtin_amdgcn_exp2f(-1.4426950408889634f * g)); }
__device__ __forceinline__ float silu_mul2(float g, float u, float c1, float c2) { return (g * u) * __builtin_amdgcn_rcpf(fmaf(__builtin_amdgcn_exp2f(g * c1), c2, c2)); }
__device__ __forceinline__ float dot4(const f32x4 a) { return (a[0] * a[0] + a[1] * a[1]) + (a[2] * a[2] + a[3] * a[3]); }

struct EpiSwiglu {
    static constexpr bool PERM = true, AFTER_DRAIN = false;
    bf16_t* H; const ssq_t* ss;
    __device__ __forceinline__ void operator()(const f32x4 (&acc)[2][2][4][2], const Unit& u, int wr, int wc, int fr, int fq) const {
        const int row0 = u.pm * BM + wr * 64 + fr, col0 = u.pn * 128 + wc * 32 + 8 * fq;
#pragma unroll
        for (int ai = 0; ai < 2; ++ai)
#pragma unroll
            for (int m = 0; m < 4; ++m) { const int row = row0 + ai * HALF + m * 16;
                const float c2 = (float)ss[row] * (1.0f / 16777216.0f) * (1.0f / 2048.0f) + 1e-6f, rs = __builtin_amdgcn_rsqf(c2), c1 = -1.4426950408889634f * rs;
                f32x4 a0, a1;
#pragma unroll
                for (int e = 0; e < 4; ++e) { a0[e] = silu_mul2(acc[ai][0][m][0][e], acc[ai][1][m][0][e], c1, c2); a1[e] = silu_mul2(acc[ai][0][m][1][e], acc[ai][1][m][1][e], c1, c2); }
                *(u32x4*)(H + (size_t)row * 5632 + col0) = pack8(a0, a1); }
    }
};
template <bool WRITE_XB = true> struct EpiResidT {
    static constexpr bool PERM = true, AFTER_DRAIN = false;
    const float* xin; float* xout; bf16_t* xb; ssq_t* ssout; float alpha;
    __device__ __forceinline__ void operator()(const f32x4 (&acc)[2][2][4][2], const Unit& u, int wr, int wc, int fr, int fq) const {
        const int row0 = u.pm * BM + wr * 64 + fr, col0 = u.pn * BM + wc * 32 + 8 * fq;
#pragma unroll
        for (int ai = 0; ai < 2; ++ai)
#pragma unroll
            for (int m = 0; m < 4; ++m) { const int row = row0 + ai * HALF + m * 16; const size_t off = (size_t)row * 2048 + col0; float sq = 0.f;
#pragma unroll
                for (int bj = 0; bj < 2; ++bj) { const f32x4 x0 = *(const f32x4*)(xin + off + bj * HALF), x1 = *(const f32x4*)(xin + off + bj * HALF + 4);
                    const f32x4 v0 = x0 + acc[ai][bj][m][0] * alpha, v1 = x1 + acc[ai][bj][m][1] * alpha;
                    *(f32x4*)(xout + off + bj * HALF) = v0; *(f32x4*)(xout + off + bj * HALF + 4) = v1;
                    if (WRITE_XB) *(u32x4*)(xb + off + bj * HALF) = pack8(v0, v1); sq += dot4(v0) + dot4(v1); }
                sq += __shfl_xor(sq, 16); sq += __shfl_xor(sq, 32);
                if (fq == 0) ss_add(ssout + row, sq); }
    }
};
typedef EpiResidT<true> EpiResid;
struct EpiScaled {
    static constexpr bool PERM = true, AFTER_DRAIN = false;
    bf16_t* O; int ldc; const ssq_t* ss; float inv_n;
    __device__ __forceinline__ void operator()(const f32x4 (&acc)[2][2][4][2], const Unit& u, int wr, int wc, int fr, int fq) const {
        const int row0 = u.pm * BM + wr * 64 + fr, col0 = u.pn * BM + wc * 32 + 8 * fq;
#pragma unroll
        for (int ai = 0; ai < 2; ++ai)
#pragma unroll
            for (int m = 0; m < 4; ++m) { const int row = row0 + ai * HALF + m * 16; const float rs = rstd_of(ss[row], inv_n);
#pragma unroll
                for (int bj = 0; bj < 2; ++bj) *(u32x4*)(O + (size_t)row * ldc + col0 + bj * HALF) = pack8(acc[ai][bj][m][0] * rs, acc[ai][bj][m][1] * rs); }
    }
};
__device__ __forceinline__ void rope8(const f32x4 x1a, const f32x4 x1b, const f32x4 x2a, const f32x4 x2b, const float* cs, int i0, u32x4& w1, u32x4& w2) {
    const f32x4 c0 = *(const f32x4*)(cs + i0), c1 = *(const f32x4*)(cs + i0 + 4), s0 = *(const f32x4*)(cs + 32 + i0), s1 = *(const f32x4*)(cs + 36 + i0);
    w1 = pack8(x1a * c0 - x2a * s0, x1b * c1 - x2b * s1); w2 = pack8(x2a * c0 + x1a * s0, x2b * c1 + x1b * s1);
}
struct EpiIn0 {
    static constexpr bool PERM = true, AFTER_DRAIN = false;
    bf16_t* Z0; bf16_t* KF; float* MG; const ssq_t* ss; ssq_t* ss_cq; ssq_t* ss_ckv; const float* CS; const float* bg;
    __device__ __forceinline__ void operator()(const f32x4 (&acc)[2][2][4][2], const Unit& u, int wr, int wc, int fr, int fq) const {
        const int row0 = u.pm * BM + wr * 64 + fr;
        if (u.pn < 16) {
            const int col0 = u.pn * BM + wc * 32 + 8 * fq;
#pragma unroll
            for (int ai = 0; ai < 2; ++ai)
#pragma unroll
                for (int m = 0; m < 4; ++m) { const int row = row0 + ai * HALF + m * 16; const float rs = rstd_of(ss[row], 1.0f / 2048.0f); float sq = 0.f;
#pragma unroll
                    for (int bj = 0; bj < 2; ++bj) { const f32x4 v0 = acc[ai][bj][m][0] * rs, v1 = acc[ai][bj][m][1] * rs;
                        *(u32x4*)(Z0 + (size_t)row * 4096 + col0 + bj * HALF) = pack8(v0, v1); sq += dot4(v0) + dot4(v1); }
                    if (u.pn < 4) { sq += __shfl_xor(sq, 16); sq += __shfl_xor(sq, 32); if (fq == 0) ss_add((u.pn < 2 ? ss_cq : ss_ckv) + row, sq); } }
        } else if (wc == 0) {
#pragma unroll
            for (int ai = 0; ai < 2; ++ai)
#pragma unroll
                for (int m = 0; m < 4; ++m) { const int row = row0 + ai * HALF + m * 16; const float rs = rstd_of(ss[row], 1.0f / 2048.0f);
                    u32x4 w1, w2; rope8(acc[ai][0][m][0] * rs, acc[ai][0][m][1] * rs, acc[ai][1][m][0] * rs, acc[ai][1][m][1] * rs, CS + (size_t)row * 64, 8 * fq, w1, w2);
                    bf16_t* kp = KF + (size_t)row * 1536 + 128 + 8 * fq;
#pragma unroll
                    for (int h = 0; h < 8; ++h) { *(u32x4*)(kp + h * 192) = w1; *(u32x4*)(kp + h * 192 + 32) = w2; } }
        } else if (wc == 1 && fq < 2) {
            const f32x4 b0 = *(const f32x4*)(bg + 8 * fq), b1 = *(const f32x4*)(bg + 8 * fq + 4);
#pragma unroll
            for (int ai = 0; ai < 2; ++ai)
#pragma unroll
                for (int m = 0; m < 4; ++m) { const int row = row0 + ai * HALF + m * 16; const float rs = rstd_of(ss[row], 1.0f / 2048.0f);
                    *(f32x4*)(MG + (size_t)row * 16 + 8 * fq) = acc[ai][0][m][0] * rs + b0; *(f32x4*)(MG + (size_t)row * 16 + 8 * fq + 4) = acc[ai][0][m][1] * rs + b1; }
        }
    }
};
struct EpiUq {
    static constexpr bool PERM = true, AFTER_DRAIN = false;
    bf16_t* Q; const ssq_t* ss_cq; const float* CS;
    __device__ __forceinline__ void operator()(const f32x4 (&acc)[2][2][4][2], const Unit& u, int wr, int wc, int fr, int fq) const {
        const int row0 = u.pm * BM + wr * 64 + fr;
#pragma unroll
        for (int ai = 0; ai < 2; ++ai)
#pragma unroll
            for (int m = 0; m < 4; ++m) { const int row = row0 + ai * HALF + m * 16; const float rs = rstd_of(ss_cq[row], 1.0f / 512.0f);
                if (u.pn < 4) {
#pragma unroll
                    for (int bj = 0; bj < 2; ++bj) *(u32x4*)(Q + (size_t)row * 1536 + (2 * u.pn + bj) * 192 + wc * 32 + 8 * fq) = pack8(acc[ai][bj][m][0] * rs, acc[ai][bj][m][1] * rs);
                } else {
                    u32x4 w1, w2; rope8(acc[ai][0][m][0] * rs, acc[ai][0][m][1] * rs, acc[ai][1][m][0] * rs, acc[ai][1][m][1] * rs, CS + (size_t)row * 64, 8 * fq, w1, w2);
                    bf16_t* qp = Q + (size_t)row * 1536 + (4 * (u.pn - 4) + wc) * 192 + 128 + 8 * fq; *(u32x4*)qp = w1; *(u32x4*)(qp + 32) = w2;
                } }
    }
};
struct EpiUkv {
    static constexpr bool PERM = true, AFTER_DRAIN = false;
    bf16_t* KF; bf16_t* V; const ssq_t* ss_ckv;
    __device__ __forceinline__ void operator()(const f32x4 (&acc)[2][2][4][2], const Unit& u, int wr, int wc, int fr, int fq) const {
        const int row0 = u.pm * BM + wr * 64 + fr;
#pragma unroll
        for (int ai = 0; ai < 2; ++ai)
#pragma unroll
            for (int m = 0; m < 4; ++m) { const int row = row0 + ai * HALF + m * 16; const float rs = rstd_of(ss_ckv[row], 1.0f / 512.0f);
                *(u32x4*)(KF + (size_t)row * 1536 + u.pn * 192 + wc * 32 + 8 * fq) = pack8(acc[ai][0][m][0] * rs, acc[ai][0][m][1] * rs);
                *(u32x4*)(V + (size_t)row * 1024 + u.pn * 128 + wc * 32 + 8 * fq) = pack8(acc[ai][1][m][0] * rs, acc[ai][1][m][1] * rs); }
    }
};

template <class Epi, class Sched, bool ALIGN_EPI = false, bool SP2 = false>
__device__ __forceinline__ void gemm_phase(PG8_LAS unsigned char* lds, const Gemm g, const Sched& S, const Epi& E, const int wave_in) {
    const int wid = __builtin_amdgcn_readfirstlane(wave_in), lane = mk_lane(), tid = wid * 64 + lane, wr = wid >> 2, wc = wid & 3, fr = lane & 15, fq = lane >> 4;
    const int K = g.K, nt = K / BK;
    unsigned voffA[2], voffB[2];
#pragma unroll
    for (int i = 0; i < 2; ++i) { int R, C; stage_rc(tid * 16 + i * 8192, R, C); const int Rb = Epi::PERM ? ((R & ~31) + perm32(R & 31)) : R;
        voffA[i] = (unsigned)(R * g.lda + C) * 2u; voffB[i] = (unsigned)(Rb * K + C) * 2u; }
    const size_t kstep = (size_t)(BK * 2);
    const size_t hstep = (size_t)HALF * K * 2, hstepA = (size_t)HALF * g.lda * 2;
    const size_t tstep = 2 * hstep, tstepA = 2 * hstepA;
    const unsigned ldsw = (unsigned)wid * 1024u;
    const int aoff = lds_byte(wr * 64 + fr, fq * 8), boff = lds_byte(wc * 32 + fr, fq * 8);
#define PG8_SA(b, h) (((b) * 2 + (h)) * HTB)
#define PG8_SB(b, h) ((4 + (b) * 2 + (h)) * HTB)
#define PG8_STAGE(bufoff, gbase, voff) do { _Pragma("unroll") for (int _i = 0; _i < 2; ++_i) \
        __builtin_amdgcn_global_load_lds((const unsigned*)((const char*)(gbase) + (voff)[_i]), (PG8_LAS unsigned*)(lds + (bufoff) + ldsw + _i * 8192), 16, 0, 0); } while (0)
#define PG8_LDA(dst, b, h) do { _Pragma("unroll") for (int m = 0; m < 4; ++m) _Pragma("unroll") for (int k = 0; k < 2; ++k) dst[m][k] = *(const PG8_LAS bf16x8*)(lds + PG8_SA(b, h) + aoff + m * 2048 + k * 1024); } while (0)
#define PG8_LDB(dst, b, h) do { _Pragma("unroll") for (int n = 0; n < 2; ++n) _Pragma("unroll") for (int k = 0; k < 2; ++k) dst[n][k] = *(const PG8_LAS bf16x8*)(lds + PG8_SB(b, h) + boff + n * 2048 + k * 1024); } while (0)
#define PG8_MMA(ai, bj, At, Bt) do { __builtin_amdgcn_s_setprio(1); _Pragma("unroll") for (int m = 0; m < 4; ++m) _Pragma("unroll") for (int n = 0; n < 2; ++n) _Pragma("unroll") for (int k = 0; k < 2; ++k) \
        acc[ai][bj][m][n] = __builtin_amdgcn_mfma_f32_16x16x32_bf16(Bt[n][k], At[m][k], acc[ai][bj][m][n], 0, 0, 0); __builtin_amdgcn_s_setprio(0); } while (0)
#define PG8_WAIT_V(n) asm volatile("s_waitcnt vmcnt(" #n ")" ::: "memory")
#define PG8_WAIT_L(n) asm volatile("s_waitcnt lgkmcnt(" #n ")" ::: "memory")
#define PG8_BAR __builtin_amdgcn_s_barrier()
#define PG8_SCHED __builtin_amdgcn_sched_barrier(0)
    Unit cur, nxt; int ui = 0;
    if (!S.next(0, cur)) return;
    f32x4 acc[2][2][4][2];
#pragma unroll
    for (int a = 0; a < 2; ++a)
#pragma unroll
        for (int b = 0; b < 2; ++b)
#pragma unroll
            for (int m = 0; m < 4; ++m)
#pragma unroll
                for (int n = 0; n < 2; ++n) acc[a][b][m][n] = (f32x4){0.f, 0.f, 0.f, 0.f};
    bf16x8 At[4][2], B0[2][2], B1[2][2];
    const char* cA = (const char*)g.A + (size_t)cur.pm * tstepA; const char* cB = (const char*)g.Bt + (size_t)cur.pn * tstep;
    S.a_ready(cur);
    if constexpr (SP2) {
        PG8_STAGE(PG8_SB(0, 0), cB, voffB); PG8_STAGE(PG8_SB(0, 1), cB + hstep, voffB); PG8_STAGE(PG8_SA(0, 0), cA, voffA); PG8_STAGE(PG8_SA(0, 1), cA + hstepA, voffA);
        if (wr == 1) PG8_BAR;
        PG8_WAIT_V(2); PG8_BAR;
        PG8_STAGE(PG8_SB(1, 0), cB + kstep, voffB); PG8_STAGE(PG8_SA(1, 0), cA + kstep, voffA); PG8_STAGE(PG8_SB(1, 1), cB + hstep + kstep, voffB);
        PG8_WAIT_V(6); PG8_BAR;
    } else {
        PG8_STAGE(PG8_SB(0, 0), cB, voffB); PG8_STAGE(PG8_SA(0, 0), cA, voffA); PG8_STAGE(PG8_SB(0, 1), cB + hstep, voffB); PG8_STAGE(PG8_SA(0, 1), cA + hstepA, voffA);
        if (wr == 1) PG8_BAR;
        PG8_WAIT_V(4); PG8_BAR;
        PG8_STAGE(PG8_SB(1, 0), cB + kstep, voffB); PG8_STAGE(PG8_SA(1, 0), cA + kstep, voffA); PG8_STAGE(PG8_SB(1, 1), cB + hstep + kstep, voffB);
        PG8_WAIT_V(6); PG8_BAR;
    }
    for (;;) {
        const bool has_next = S.next(ui + 1, nxt);
        const char* nA = has_next ? (const char*)g.A + (size_t)nxt.pm * tstepA : cA; const char* nB = has_next ? (const char*)g.Bt + (size_t)nxt.pn * tstep : cB;
        for (int t = 0; t < nt; t += 2) {
            const bool last = (t == nt - 2);
            const char* a1 = cA + (size_t)(t + 1) * kstep;
            const char* a2 = last ? nA : cA + (size_t)(t + 2) * kstep; const char* b2 = last ? nB : cB + (size_t)(t + 2) * kstep;
            const char* a3 = a2 + kstep; const char* b3 = b2 + kstep;
            if (last && has_next) S.a_ready(nxt);
            if constexpr (SP2) {
            PG8_LDB(B0, 0, 0); PG8_LDB(B1, 0, 1); PG8_SCHED; PG8_LDA(At, 0, 0); PG8_STAGE(PG8_SA(1, 1), a1 + hstepA, voffA);
            PG8_WAIT_V(8); PG8_WAIT_L(0); PG8_BAR; PG8_MMA(0, 0, At, B0); PG8_MMA(0, 1, At, B1); PG8_BAR; PG8_SCHED;
            PG8_LDA(At, 0, 1); PG8_STAGE(PG8_SB(0, 0), b2, voffB); PG8_STAGE(PG8_SB(0, 1), b2 + hstep, voffB); PG8_STAGE(PG8_SA(0, 0), a2, voffA);
            PG8_WAIT_V(8); PG8_WAIT_L(0); PG8_BAR; PG8_MMA(1, 0, At, B0); PG8_MMA(1, 1, At, B1); PG8_BAR; PG8_SCHED;
            PG8_LDB(B0, 1, 0); PG8_LDB(B1, 1, 1); PG8_SCHED; PG8_LDA(At, 1, 0); PG8_STAGE(PG8_SA(0, 1), a2 + hstepA, voffA);
            PG8_WAIT_V(8); PG8_WAIT_L(0); PG8_BAR; PG8_MMA(0, 0, At, B0); PG8_MMA(0, 1, At, B1); PG8_BAR; PG8_SCHED;
            PG8_LDA(At, 1, 1); PG8_STAGE(PG8_SB(1, 0), b3, voffB); PG8_STAGE(PG8_SB(1, 1), b3 + hstep, voffB); PG8_STAGE(PG8_SA(1, 0), a3, voffA);
            PG8_WAIT_V(8); PG8_WAIT_L(0); PG8_BAR; PG8_MMA(1, 0, At, B0); PG8_MMA(1, 1, At, B1); PG8_BAR; PG8_SCHED;
            } else {
            PG8_LDB(B0, 0, 0); PG8_SCHED; PG8_LDA(At, 0, 0); PG8_STAGE(PG8_SA(1, 1), a1 + hstepA, voffA);
            PG8_WAIT_L(8); PG8_BAR; PG8_WAIT_L(0); PG8_MMA(0, 0, At, B0); PG8_BAR; PG8_SCHED;
            PG8_LDB(B1, 0, 1); PG8_STAGE(PG8_SB(0, 0), b2, voffB);
            PG8_BAR; PG8_WAIT_L(0); PG8_MMA(0, 1, At, B1); PG8_BAR;
            PG8_LDA(At, 0, 1); PG8_STAGE(PG8_SA(0, 0), a2, voffA);
            PG8_BAR; PG8_WAIT_L(0); PG8_MMA(1, 0, At, B0); PG8_BAR; PG8_SCHED;
            PG8_STAGE(PG8_SB(0, 1), b2 + hstep, voffB);
            PG8_WAIT_V(6); PG8_BAR; PG8_MMA(1, 1, At, B1); PG8_BAR;
            PG8_LDB(B0, 1, 0); PG8_SCHED; PG8_LDA(At, 1, 0); PG8_STAGE(PG8_SA(0, 1), a2 + hstepA, voffA);
            PG8_WAIT_L(8); PG8_BAR; PG8_WAIT_L(0); PG8_MMA(0, 0, At, B0); PG8_BAR; PG8_SCHED;
            PG8_LDB(B1, 1, 1); PG8_STAGE(PG8_SB(1, 0), b3, voffB);
            PG8_BAR; PG8_WAIT_L(0); PG8_MMA(0, 1, At, B1); PG8_BAR;
            PG8_LDA(At, 1, 1); PG8_STAGE(PG8_SA(1, 0), a3, voffA);
            PG8_BAR; PG8_WAIT_L(0); PG8_MMA(1, 0, At, B0); PG8_BAR; PG8_SCHED;
            PG8_STAGE(PG8_SB(1, 1), b3 + hstep, voffB);
            PG8_WAIT_V(6); PG8_BAR; PG8_MMA(1, 1, At, B1); PG8_BAR;
            }
        }
        if constexpr (ALIGN_EPI) { if (wr == 0) PG8_BAR; }
        if constexpr (!Epi::AFTER_DRAIN) { E(acc, cur, wr, wc, fr, fq); S.done(cur); }
        if (!has_next) break;
#pragma unroll
        for (int a = 0; a < 2; ++a)
#pragma unroll
            for (int b = 0; b < 2; ++b)
#pragma unroll
                for (int m = 0; m < 4; ++m)
#pragma unroll
                    for (int n = 0; n < 2; ++n) acc[a][b][m][n] = (f32x4){0.f, 0.f, 0.f, 0.f};
        cur = nxt; cA = nA; cB = nB; ++ui;
        if constexpr (ALIGN_EPI) { if (wr == 1) PG8_BAR; }
    }
    PG8_WAIT_V(0);
    if constexpr (!ALIGN_EPI) { if (wr == 0) PG8_BAR; }
    PG8_BAR;
    if constexpr (Epi::AFTER_DRAIN) { E.fused(acc, cur, wr, wc, fr, fq, lds, wid, lane); S.done(cur); }
#undef PG8_SA
#undef PG8_SB
#undef PG8_STAGE
#undef PG8_LDA
#undef PG8_LDB
#undef PG8_MMA
#undef PG8_WAIT_V
#undef PG8_WAIT_L
#undef PG8_BAR
#undef PG8_SCHED
}
}

namespace att {
typedef unsigned short bf16_t;
using bf16x8 = __attribute__((ext_vector_type(8))) short;
using s16x4  = __attribute__((ext_vector_type(4))) short;
using f32x16 = __attribute__((ext_vector_type(16))) float;
using f32x4  = __attribute__((ext_vector_type(4))) float;
using u32x4  = __attribute__((ext_vector_type(4))) unsigned;
constexpr int NW = 8, QBLK = 32, KVBLK = 64;
constexpr int SHM_V = 16384, SHM_KMAX = 64 * 192 * 2;
constexpr int OFF_V = 0, OFF_K = 2 * SHM_V, OFF_WS = OFF_K + 2 * SHM_KMAX, OFF_AUX = OFF_WS + NW * 64 * 4, LDS_ATT = OFF_AUX + 4096 * 4;
#define SBAR() __builtin_amdgcn_sched_barrier(0)
__device__ __forceinline__ int crow(int r, int hi) { return (r & 3) + 8 * (r >> 2) + 4 * hi; }
typedef float f32x2_t __attribute__((ext_vector_type(2))); typedef __bf16 bf16x2_t __attribute__((ext_vector_type(2)));
__device__ __forceinline__ unsigned cvtpk(float lo, float hi) { f32x2_t v = {lo, hi}; bf16x2_t b = __builtin_convertvector(v, bf16x2_t); return __builtin_bit_cast(unsigned, b); }
__device__ __forceinline__ int v_st(int k, int c) { const int kk = (k & ~0xC) | ((k & 4) << 1) | ((k & 8) >> 1); return ((kk >> 3) * 4 + (c >> 5)) * 512 + ((kk & 7) * 32 + (c & 31)) * 2; }
__device__ __forceinline__ int v_rd_base(int lane) { return ((lane & 3) << 3) | (((lane >> 2) & 3) << 6) | (((lane >> 4) & 1) << 5) | (((lane >> 5) & 1) << 8); }
constexpr int v_rd_off(int d0, int ks, int half) { return d0 * 512 + ks * 4096 + half * 2048; }
template <int OFF> __device__ __forceinline__ s16x4 tr_read(int vb) { s16x4 r; asm volatile("ds_read_b64_tr_b16 %0, %1 offset:%2" : "=&v"(r) : "v"(vb), "i"(OFF) : "memory"); return r; }
template <int D0> __device__ __forceinline__ void pv_one(f32x16& od, int vb, bf16x8 pa0, bf16x8 pa1, bf16x8 pa2, bf16x8 pa3) {
  const s16x4 l0 = tr_read<v_rd_off(D0, 0, 0)>(vb), h0 = tr_read<v_rd_off(D0, 0, 1)>(vb), l1 = tr_read<v_rd_off(D0, 1, 0)>(vb), h1 = tr_read<v_rd_off(D0, 1, 1)>(vb);
  const s16x4 l2 = tr_read<v_rd_off(D0, 2, 0)>(vb), h2 = tr_read<v_rd_off(D0, 2, 1)>(vb), l3 = tr_read<v_rd_off(D0, 3, 0)>(vb), h3 = tr_read<v_rd_off(D0, 3, 1)>(vb);
  asm volatile("s_waitcnt lgkmcnt(0)" ::: "memory"); SBAR();
#define PK(L, H) (bf16x8){L[0], L[1], L[2], L[3], H[0], H[1], H[2], H[3]}
  od = __builtin_amdgcn_mfma_f32_32x32x16_bf16(pa0, PK(l0, h0), od, 0, 0, 0);
  od = __builtin_amdgcn_mfma_f32_32x32x16_bf16(pa1, PK(l1, h1), od, 0, 0, 0);
  od = __builtin_amdgcn_mfma_f32_32x32x16_bf16(pa2, PK(l2, h2), od, 0, 0, 0);
  od = __builtin_amdgcn_mfma_f32_32x32x16_bf16(pa3, PK(l3, h3), od, 0, 0, 0);
#undef PK
}
__device__ __forceinline__ void pv_d0(f32x16* o, int vb, bf16x8 pa0, bf16x8 pa1, bf16x8 pa2, bf16x8 pa3) {
  pv_one<0>(o[0], vb, pa0, pa1, pa2, pa3); pv_one<1>(o[1], vb, pa0, pa1, pa2, pa3); pv_one<2>(o[2], vb, pa0, pa1, pa2, pa3); pv_one<3>(o[3], vb, pa0, pa1, pa2, pa3);
}
#define PK4(P, BASE, OUT) do { unsigned a0 = cvtpk(P[BASE + 0], P[BASE + 1]), a1 = cvtpk(P[BASE + 2], P[BASE + 3]);   \
    unsigned b0 = cvtpk(P[BASE + 4], P[BASE + 5]), b1 = cvtpk(P[BASE + 6], P[BASE + 7]);                              \
    auto r0 = __builtin_amdgcn_permlane32_swap(a0, b0, false, false); auto r1 = __builtin_amdgcn_permlane32_swap(a1, b1, false, false); \
    u32x4 w = {r0[0], r1[0], r0[1], r1[1]}; OUT = *reinterpret_cast<bf16x8*>(&w); } while (0)

struct AttnUnit {
  const bf16_t* Q; const bf16_t* K; const bf16_t* V; bf16_t* O;
  int ldq, ldk, ldv, ldo;
  int jt0, NT, q0, wid;
  float C, thr;
  const int* posg; float nsl;
  const float* Ag; const float* Bg; const float* Eg; float lscale;
};

template <int MODE> __device__ __forceinline__ void partialSM(f32x16& p0, f32x16& p1, float& m_reg, float& mn, float& alpha, float C, float thr, const float* auxk, float pq, float nsl, int hi) {
  if (MODE == 1) {
#pragma unroll
    for (int g = 0; g < 4; ++g) { const f32x4 a = *(const f32x4*)(auxk + 8 * g + 4 * hi), b = *(const f32x4*)(auxk + 32 + 8 * g + 4 * hi);
#pragma unroll
      for (int e = 0; e < 4; ++e) { p0[4 * g + e] = fmaf(fabsf(pq - a[e]), nsl, p0[4 * g + e]); p1[4 * g + e] = fmaf(fabsf(pq - b[e]), nsl, p1[4 * g + e]); } }
  }
  float pmax = p0[0];
#pragma unroll
  for (int r = 1; r < 16; ++r) pmax = fmaxf(pmax, p0[r]);
#pragma unroll
  for (int r = 0; r < 16; ++r) pmax = fmaxf(pmax, p1[r]);
  { auto rr = __builtin_amdgcn_permlane32_swap(__float_as_uint(pmax), __float_as_uint(pmax), false, false);
    pmax = fmaxf(__uint_as_float(rr[0]), __uint_as_float(rr[1])); }
  if (__builtin_expect(__all(pmax - m_reg <= thr), 1)) { mn = m_reg; alpha = 1.f; }
  else { mn = fmaxf(m_reg, pmax); alpha = __builtin_amdgcn_exp2f((m_reg - mn) * C); m_reg = mn; }
  const float mnC = -mn * C;
#pragma unroll
  for (int r = 0; r < 16; ++r) p0[r] = fmaf(p0[r], C, mnC);
#pragma unroll
  for (int r = 0; r < 16; ++r) p1[r] = fmaf(p1[r], C, mnC);
#pragma unroll
  for (int r = 0; r < 16; ++r) p0[r] = __builtin_amdgcn_exp2f(p0[r]);
}
__device__ __forceinline__ void finishSM(f32x16& p0, f32x16& p1, float alpha, float& l_reg, bf16x8& pa0, bf16x8& pa1, bf16x8& pa2, bf16x8& pa3) {
#pragma unroll
  for (int r = 0; r < 16; ++r) p1[r] = __builtin_amdgcn_exp2f(p1[r]);
  float ps = 0;
#pragma unroll
  for (int r = 0; r < 16; ++r) ps += p0[r];
#pragma unroll
  for (int r = 0; r < 16; ++r) ps += p1[r];
  { auto rr = __builtin_amdgcn_permlane32_swap(__float_as_uint(ps), __float_as_uint(ps), false, false);
    ps = __uint_as_float(rr[0]) + __uint_as_float(rr[1]); }
  l_reg = l_reg * alpha + ps;
  PK4(p0, 0, pa0); PK4(p0, 8, pa1); PK4(p1, 0, pa2); PK4(p1, 8, pa3);
}
template <int MODE> __device__ __forceinline__ void partialW(f32x16& p0, f32x16& p1, const float* auxk, float At, bool band, int qrel, int hi) {
#pragma unroll
  for (int g = 0; g < 4; ++g) { const f32x4 a = *(const f32x4*)(auxk + 8 * g + 4 * hi), b = *(const f32x4*)(auxk + 32 + 8 * g + 4 * hi);
#pragma unroll
    for (int e = 0; e < 4; ++e) { p0[4 * g + e] *= __builtin_amdgcn_exp2f(At - a[e]); p1[4 * g + e] *= __builtin_amdgcn_exp2f(At - b[e]); } }
  if (band) {
#pragma unroll
    for (int r = 0; r < 16; ++r) { const int kvl = (r & 3) + 8 * (r >> 2);
      const bool k0 = (MODE == 2) ? (kvl <= qrel) : (kvl >= qrel), k1 = (MODE == 2) ? (kvl + 32 <= qrel) : (kvl + 32 >= qrel);
      p0[r] = k0 ? p0[r] : 0.f; p1[r] = k1 ? p1[r] : 0.f; }
  }
}
template <int MODE> __device__ __forceinline__ void partialW2(f32x16& p0, f32x16& p1, const float* auxk, bool band, int qrel, int hi) {
#pragma unroll
  for (int g = 0; g < 4; ++g) { const f32x4 a = *(const f32x4*)(auxk + 8 * g + 4 * hi), b = *(const f32x4*)(auxk + 32 + 8 * g + 4 * hi);
#pragma unroll
    for (int e = 0; e < 4; ++e) { p0[4 * g + e] *= a[e]; p1[4 * g + e] *= b[e]; } }
  if (band) {
#pragma unroll
    for (int r = 0; r < 16; ++r) { const int kvl = (r & 3) + 8 * (r >> 2);
      const bool k0 = (MODE == 2) ? (kvl <= qrel) : (kvl >= qrel), k1 = (MODE == 2) ? (kvl + 32 <= qrel) : (kvl + 32 >= qrel);
      p0[r] = k0 ? p0[r] : 0.f; p1[r] = k1 ? p1[r] : 0.f; }
  }
}
__device__ __forceinline__ void finishW(f32x16& p0, f32x16& p1, float& l_reg, bf16x8& pa0, bf16x8& pa1, bf16x8& pa2, bf16x8& pa3) {
  float ps = 0;
#pragma unroll
  for (int r = 0; r < 16; ++r) ps += p0[r];
#pragma unroll
  for (int r = 0; r < 16; ++r) ps += p1[r];
  { auto rr = __builtin_amdgcn_permlane32_swap(__float_as_uint(ps), __float_as_uint(ps), false, false);
    ps = __uint_as_float(rr[0]) + __uint_as_float(rr[1]); }
  l_reg += ps;
  PK4(p0, 0, pa0); PK4(p0, 8, pa1); PK4(p1, 0, pa2); PK4(p1, 8, pa3);
}
template <int DQK, bool BIAS = false> __device__ __forceinline__ void qkt(f32x16& p0, f32x16& p1, const char* Ks, const bf16x8* qr, int r32, int hi, const float* auxk = nullptr, float pq = 0.f, float nsl = 0.f) {
  constexpr int ROWB = DQK * 2;
  if (BIAS) {
#pragma unroll
    for (int g = 0; g < 4; ++g) { const f32x4 a = *(const f32x4*)(auxk + 8 * g + 4 * hi), b = *(const f32x4*)(auxk + 32 + 8 * g + 4 * hi);
#pragma unroll
      for (int e = 0; e < 4; ++e) { p0[4 * g + e] = fabsf(pq - a[e]) * nsl; p1[4 * g + e] = fabsf(pq - b[e]) * nsl; } }
  } else { p0 = f32x16{}; p1 = f32x16{}; }
  const int sw = (r32 & 7) << 4; const char* k0p = Ks + r32 * ROWB; const char* k1p = Ks + (32 + r32) * ROWB;
#pragma unroll
  for (int d0 = 0; d0 < DQK / 16; ++d0) { const int cb = ((d0 * 16 + hi * 8) * 2) ^ sw;
    const bf16x8 b0 = *reinterpret_cast<const bf16x8*>(k0p + cb);
    const bf16x8 b1 = *reinterpret_cast<const bf16x8*>(k1p + cb);
    p0 = __builtin_amdgcn_mfma_f32_32x32x16_bf16(b0, qr[d0], p0, 0, 0, 0);
    p1 = __builtin_amdgcn_mfma_f32_32x32x16_bf16(b1, qr[d0], p1, 0, 0, 0); }
}

#define OPQ(x) ({ int t_ = (x); asm volatile("" : "+v"(t_)); t_; })
__device__ __forceinline__ void glds16(const void* gsrc, unsigned lds_dst) { unsigned keep;
  asm volatile("s_mov_b32 %0, m0\n\ts_mov_b32 m0, %2\n\ts_nop 0\n\tglobal_load_lds_dwordx4 %1, off\n\ts_mov_b32 m0, %0" : "=&s"(keep) : "v"(gsrc), "s"(lds_dst) : "memory"); }
constexpr int R_OFF_V = 0, R_OFF_K = 3 * SHM_V, R_OFF_WS = R_OFF_K + 3 * SHM_KMAX, R_OFF_AUX = R_OFF_WS + NW * 64 * 4, R_LDS = R_OFF_AUX + 4096 * 4;
template <int DQK, int MODE>
__device__ __forceinline__ void attn_unit_dma(const AttnUnit& U, char* lds) {
  constexpr int ND0 = DQK / 16, CPR = DQK / 8, NKC = (64 * CPR) / 512, SHM_K = 64 * DQK * 2, NPT = NKC + 2;
  constexpr int PM = (MODE == 1) ? 0 : MODE;
  const int wid = __builtin_amdgcn_readfirstlane(U.wid), lane = mk_lane(), tid = wid * 64 + lane, r32 = lane & 31, hi = lane >> 5;
  char* V_lds = lds + R_OFF_V; char* K_lds = lds + R_OFF_K;
  float* ws = (float*)(lds + R_OFF_WS) + wid * 64; float* li_l = ws; float* al_l = ws + 32;
  float* aux = (float*)(lds + R_OFF_AUX);
  const unsigned lds0 = (unsigned)(uintptr_t)lds;
  float m_reg = -1e30f, l_reg = 0; f32x16 o[4] = {}; bf16x8 qr[ND0];
  { const int qoff = (wid * QBLK + r32) * U.ldq + hi * 8;
#pragma unroll
    for (int d0 = 0; d0 < ND0; ++d0) qr[d0] = *reinterpret_cast<const bf16x8*>(U.Q + (qoff + d0 * 16)); }
  const int qrow = U.q0 + wid * QBLK + r32;
  float pq = 0.f, At = 0.f, Et = 0.f;
  if (MODE == 1) { for (int i = tid; i < 4096; i += 512) aux[i] = (float)U.posg[i]; pq = (float)U.posg[qrow]; }
  if (MODE >= 2) { for (int i = tid; i < 4096; i += 512) aux[i] = U.Bg[i]; At = U.Ag[qrow] + U.lscale; Et = U.Eg[qrow]; }
  int ksrc[NKC], vsrc[2];
#pragma unroll
  for (int i = 0; i < NKC; ++i) { const int L = i * 512 + wid * 64 + lane, row = L / CPR, cs = L - row * CPR, c = cs ^ (row & 7); ksrc[i] = row * U.ldk + c * 8; }
#pragma unroll
  for (int i = 0; i < 2; ++i) { const int L = i * 512 + wid * 64 + lane, blk = L >> 5, kk = (blk >> 2) * 8 + ((L & 31) >> 2), col = (blk & 3) * 32 + (L & 3) * 8;
    const int k = (kk & ~0xC) | ((kk & 4) << 1) | ((kk & 8) >> 1); vsrc[i] = k * U.ldv + col; }
  const unsigned kdst = lds0 + R_OFF_K + wid * 1024, vdst = lds0 + R_OFF_V + wid * 1024;
  const int vb0 = (int)lds0 + R_OFF_V + v_rd_base(lane);
  const bf16_t* Kt = U.K + (long)U.jt0 * KVBLK * U.ldk; const bf16_t* Vt = U.V + (long)U.jt0 * KVBLK * U.ldv;
  const long kstep = (long)KVBLK * U.ldk, vstep = (long)KVBLK * U.ldv;
#define DMA_TILE(t, stg) do { const bf16_t* kp_ = Kt + (long)(t) * kstep; const bf16_t* vp_ = Vt + (long)(t) * vstep; \
    _Pragma("unroll") for (int i_ = 0; i_ < NKC; ++i_) glds16(kp_ + ksrc[i_], (unsigned)__builtin_amdgcn_readfirstlane(kdst + (stg) * SHM_K + i_ * 8192)); \
    _Pragma("unroll") for (int i_ = 0; i_ < 2; ++i_) glds16(vp_ + vsrc[i_], (unsigned)__builtin_amdgcn_readfirstlane(vdst + (stg) * SHM_V + i_ * 8192)); } while (0)
#define WAIT_BAR_N() asm volatile("s_waitcnt vmcnt(%0) lgkmcnt(0)\n\ts_barrier" :: "n"(NPT) : "memory")
#define WAIT_BAR_0() asm volatile("s_waitcnt vmcnt(0) lgkmcnt(0)\n\ts_barrier" ::: "memory")
#define RESC(a) do { if (MODE < 2) { if (__any((a) < 1.f)) { if (hi == 0) al_l[r32] = (a); asm volatile("s_waitcnt lgkmcnt(0)" ::: "memory"); \
    _Pragma("unroll") for (int d = 0; d < 4; ++d) _Pragma("unroll") for (int r = 0; r < 16; ++r) o[d][r] *= al_l[crow(r, hi)]; } } } while (0)
#define KB(j) ((U.jt0 + (j)) * KVBLK)
#define BAND(j) ((MODE == 2) ? (KB(j) + 63 > U.q0) : (KB(j) < U.q0 + 255))
#define PARTIAL(P0, P1, j, MN, AL) do { if (MODE < 2) partialSM<PM>(P0, P1, m_reg, MN, AL, U.C, U.thr, aux, 0.f, 0.f, hi); \
    else partialW<MODE>(P0, P1, aux + KB(j), At, BAND(j), qrow - KB(j) - 4 * hi, hi); } while (0)
#define FINISH(P0, P1, AL) do { if (MODE < 2) finishSM(P0, P1, AL, l_reg, pa0, pa1, pa2, pa3); else finishW(P0, P1, l_reg, pa0, pa1, pa2, pa3); } while (0)
  f32x16 pA0, pA1; float mnA = 0.f, alA = 1.f; bf16x8 pa0, pa1, pa2, pa3; const int NT = U.NT;
  DMA_TILE(0, 0); DMA_TILE(1, 1);
  WAIT_BAR_N();
  int st = 0, st2 = 2;
  for (int j = 0; j < NT; ++j) {
    if (j + 2 < NT) DMA_TILE(j + 2, st2);
    SBAR(); qkt<DQK, MODE == 1>(pA0, pA1, K_lds + st * SHM_K, qr, r32, hi, aux + KB(j), pq, U.nsl); SBAR();
    PARTIAL(pA0, pA1, j, mnA, alA);
    RESC(alA);
    FINISH(pA0, pA1, alA); SBAR();
    pv_d0(o, vb0 + st * SHM_V, pa0, pa1, pa2, pa3);
    if (j + 2 < NT) WAIT_BAR_N(); else WAIT_BAR_0();
    st = (st == 2) ? 0 : st + 1; st2 = (st2 == 2) ? 0 : st2 + 1;
  }
  { const float lfin = (MODE < 2) ? l_reg : fmaxf(fabsf(l_reg), Et);
    if (hi == 0) li_l[r32] = lfin; asm volatile("s_waitcnt lgkmcnt(0)" ::: "memory"); }
  { const int obase = (wid * QBLK + 4 * hi) * U.ldo + r32;
#pragma unroll
    for (int r = 0; r < 16; ++r) { const int orl = (r & 3) + 8 * (r >> 2); const float rl = __builtin_amdgcn_rcpf(li_l[orl + 4 * hi]); const int ooff = obase + orl * U.ldo;
#pragma unroll
      for (int d0 = 0; d0 < 4; ++d0) U.O[ooff + d0 * 32] = (bf16_t)(cvtpk(o[d0][r] * rl, 0.f) & 0xffffu); } }
#undef DMA_TILE
#undef WAIT_BAR_N
#undef WAIT_BAR_0
#undef RESC
#undef KB
#undef BAND
#undef PARTIAL
#undef FINISH
}

template <int DQK> __device__ __forceinline__ void qkt_acc(f32x16& p0, f32x16& p1, const char* Ks, const bf16x8* qr, int r32, int hi) {
  constexpr int ROWB = DQK * 2;
  const int sw = (r32 & 7) << 4; const char* k0p = Ks + r32 * ROWB; const char* k1p = Ks + (32 + r32) * ROWB;
#pragma unroll
  for (int d0 = 0; d0 < DQK / 16; ++d0) { const int cb = ((d0 * 16 + hi * 8) * 2) ^ sw;
    const bf16x8 b0 = *reinterpret_cast<const bf16x8*>(k0p + cb);
    const bf16x8 b1 = *reinterpret_cast<const bf16x8*>(k1p + cb);
    p0 = __builtin_amdgcn_mfma_f32_32x32x16_bf16(b0, qr[d0], p0, 0, 0, 0);
    p1 = __builtin_amdgcn_mfma_f32_32x32x16_bf16(b1, qr[d0], p1, 0, 0, 0); }
}
__device__ __forceinline__ float rowmax32(const f32x16& p0, const f32x16& p1) {
  float pmax = p0[0];
#pragma unroll
  for (int r = 1; r < 16; ++r) pmax = fmaxf(pmax, p0[r]);
#pragma unroll
  for (int r = 0; r < 16; ++r) pmax = fmaxf(pmax, p1[r]);
  auto rr = __builtin_amdgcn_permlane32_swap(__float_as_uint(pmax), __float_as_uint(pmax), false, false);
  return fmaxf(__uint_as_float(rr[0]), __uint_as_float(rr[1]));
}
__device__ __forceinline__ void partialSM_rc(f32x16& p0, f32x16& p1, float& m_reg, float& mn, float& alpha, float C, float thr, float rc, float pmax) {
  if (__builtin_expect(__all(pmax - m_reg <= thr), 1)) { mn = m_reg; alpha = 1.f; }
  else { mn = fmaxf(m_reg, pmax); alpha = __builtin_amdgcn_exp2f((m_reg - mn) * C); m_reg = mn; }
  const float mnC = (rc - mn) * C;
#pragma unroll
  for (int r = 0; r < 16; ++r) p0[r] = fmaf(p0[r], C, mnC);
#pragma unroll
  for (int r = 0; r < 16; ++r) p1[r] = fmaf(p1[r], C, mnC);
#pragma unroll
  for (int r = 0; r < 16; ++r) p0[r] = __builtin_amdgcn_exp2f(p0[r]);
}
template <int D0> __device__ __forceinline__ void pv_one_lean(f32x16& od, int vb, bf16x8 pa0, bf16x8 pa1, bf16x8 pa2, bf16x8 pa3) {
#define PKL(L, H) (bf16x8){L[0], L[1], L[2], L[3], H[0], H[1], H[2], H[3]}
  { const s16x4 l0 = tr_read<v_rd_off(D0, 0, 0)>(vb), h0 = tr_read<v_rd_off(D0, 0, 1)>(vb), l1 = tr_read<v_rd_off(D0, 1, 0)>(vb), h1 = tr_read<v_rd_off(D0, 1, 1)>(vb);
    asm volatile("s_waitcnt lgkmcnt(0)" ::: "memory"); SBAR();
    od = __builtin_amdgcn_mfma_f32_32x32x16_bf16(pa0, PKL(l0, h0), od, 0, 0, 0); od = __builtin_amdgcn_mfma_f32_32x32x16_bf16(pa1, PKL(l1, h1), od, 0, 0, 0); }
  SBAR();
  { const s16x4 l2 = tr_read<v_rd_off(D0, 2, 0)>(vb), h2 = tr_read<v_rd_off(D0, 2, 1)>(vb), l3 = tr_read<v_rd_off(D0, 3, 0)>(vb), h3 = tr_read<v_rd_off(D0, 3, 1)>(vb);
    asm volatile("s_waitcnt lgkmcnt(0)" ::: "memory"); SBAR();
    od = __builtin_amdgcn_mfma_f32_32x32x16_bf16(pa2, PKL(l2, h2), od, 0, 0, 0); od = __builtin_amdgcn_mfma_f32_32x32x16_bf16(pa3, PKL(l3, h3), od, 0, 0, 0); }
#undef PKL
}
__device__ __forceinline__ void pv_d0_lean(f32x16* o, int vb, bf16x8 pa0, bf16x8 pa1, bf16x8 pa2, bf16x8 pa3) {
  pv_one_lean<0>(o[0], vb, pa0, pa1, pa2, pa3); SBAR(); pv_one_lean<1>(o[1], vb, pa0, pa1, pa2, pa3); SBAR(); pv_one_lean<2>(o[2], vb, pa0, pa1, pa2, pa3); SBAR(); pv_one_lean<3>(o[3], vb, pa0, pa1, pa2, pa3);
}
constexpr int A_OFF_V = 0, A_OFF_K = 2 * 32768, A_OFF_WS = A_OFF_K + 2 * 16384, A_OFF_AUX = A_OFF_WS + NW * 64 * 4, A_LDS = A_OFF_AUX + 4096 * 4 + 256;
__device__ __forceinline__ void attn_unit_da(const AttnUnit& U, char* lds) {
  constexpr int DQK = 128, ND0 = 8, SHM_K = 16384, SHM_V2 = 32768;
  const int wid = __builtin_amdgcn_readfirstlane(U.wid), lane = mk_lane(), tid = wid * 64 + lane, r32 = lane & 31, hi = lane >> 5;
  char* K_lds = lds + A_OFF_K;
  float* ws = (float*)(lds + A_OFF_WS) + wid * 64; float* li_l = ws; float* al_l = ws + 32;
  float* aux = (float*)(lds + A_OFF_AUX); int* cls = (int*)(lds + A_OFF_AUX + 4096 * 4);
  const unsigned lds0 = (unsigned)(uintptr_t)lds;
  float m_reg = -1e30f, l_reg = 0; f32x16 o[8] = {}; bf16x8 qr[ND0];
  { const int qoff = (wid * QBLK + r32) * U.ldq + hi * 8;
#pragma unroll
    for (int d0 = 0; d0 < ND0; ++d0) qr[d0] = *reinterpret_cast<const bf16x8*>(U.Q + (qoff + d0 * 16)); }
  const int qrow = U.q0 + wid * QBLK + r32;
  const int pq0i = U.posg[U.q0];
  int pmin, pmax;
  { int a0 = U.posg[U.q0 + lane], a1 = U.posg[U.q0 + 64 + lane], a2 = U.posg[U.q0 + 128 + lane], a3 = U.posg[U.q0 + 192 + lane];
    int mnv = min(min(a0, a1), min(a2, a3)), mxv = max(max(a0, a1), max(a2, a3));
#pragma unroll
    for (int of = 1; of < 64; of <<= 1) { mnv = min(mnv, __shfl_xor(mnv, of)); mxv = max(mxv, __shfl_xor(mxv, of)); }
    pmin = __builtin_amdgcn_readfirstlane(mnv); pmax = __builtin_amdgcn_readfirstlane(mxv); }
  const float pq = (float)(U.posg[qrow] - pq0i);
  for (int i = tid; i < 4096; i += 512) { const int pk = U.posg[i]; const float rel = (float)(pk - pq0i) * U.nsl; aux[i] = (pk <= pmin && pk < pmax) ? -rel : ((pk >= pmax) ? rel : 0.f); }
#pragma unroll
  for (int k = 0; k < 8; ++k) { const int t = wid * 8 + k; int v = U.posg[t * 64 + lane], mnv = v, mxv = v;
#pragma unroll
    for (int of = 1; of < 64; of <<= 1) { mnv = min(mnv, __shfl_xor(mnv, of)); mxv = max(mxv, __shfl_xor(mxv, of)); }
    if (lane == 0) cls[t] = (mxv <= pmin && mxv < pmax) ? 0 : ((mnv >= pmax) ? 1 : 2); }
  const unsigned kdst = lds0 + A_OFF_K + wid * 1024, vdst = lds0 + A_OFF_V + wid * 1024;
  const int vb0 = (int)lds0 + A_OFF_V + v_rd_base(lane);
  const long kstep = (long)KVBLK * U.ldk, vstep = (long)KVBLK * U.ldv;
#define DMA_TILE(t, stg) do { const bf16_t* kp_ = U.K + (long)(t) * kstep; const bf16_t* vp_ = U.V + (long)(t) * vstep; const int tl_ = OPQ(tid) & 511;     \
    _Pragma("unroll") for (int i_ = 0; i_ < 2; ++i_) { const int L_ = i_ * 512 + tl_, row_ = L_ >> 4, c_ = (L_ & 15) ^ (row_ & 7); \
      glds16(kp_ + (row_ * U.ldk + c_ * 8), (unsigned)__builtin_amdgcn_readfirstlane(kdst + (stg) * SHM_K + i_ * 8192)); } \
    _Pragma("unroll") for (int i_ = 0; i_ < 2; ++i_) { const int L_ = i_ * 512 + tl_, blk_ = L_ >> 5, kk_ = (blk_ >> 2) * 8 + ((L_ & 31) >> 2), col_ = (blk_ & 3) * 32 + (L_ & 3) * 8; \
      const int k_ = (kk_ & ~0xC) | ((kk_ & 4) << 1) | ((kk_ & 8) >> 1); const bf16_t* vs_ = vp_ + (k_ * U.ldv + col_); \
      glds16(vs_, (unsigned)__builtin_amdgcn_readfirstlane(vdst + (stg) * SHM_V2 + i_ * 8192)); \
      glds16(vs_ + 128, (unsigned)__builtin_amdgcn_readfirstlane(vdst + (stg) * SHM_V2 + 16384 + i_ * 8192)); } } while (0)
#define WAIT_BAR_0() asm volatile("s_waitcnt vmcnt(0) lgkmcnt(0)\n\ts_barrier" ::: "memory")
  f32x16 p0, p1; float mn = 0.f, al = 1.f; bf16x8 pa0, pa1, pa2, pa3; const int NT = U.NT;
  DMA_TILE(0, 0);
  WAIT_BAR_0();
  for (int j = 0; j < NT; ++j) {
    const int st = j & 1;
    if (j + 1 < NT) DMA_TILE(j + 1, st ^ 1);
    float rc;
    { const int c_ = __builtin_amdgcn_readfirstlane(cls[j]); const float* ak_ = aux + j * KVBLK;
      if (c_ < 2) { rc = (c_ == 0) ? pq * U.nsl : -pq * U.nsl;
#pragma unroll
        for (int g = 0; g < 4; ++g) { const f32x4 a_ = *(const f32x4*)(ak_ + 8 * g + 4 * hi), b_ = *(const f32x4*)(ak_ + 32 + 8 * g + 4 * hi);
#pragma unroll
          for (int e = 0; e < 4; ++e) { p0[4 * g + e] = a_[e]; p1[4 * g + e] = b_[e]; } } }
      else { rc = 0.f; const int* pg_ = U.posg + j * KVBLK;
#pragma unroll
        for (int g = 0; g < 4; ++g)
#pragma unroll
          for (int e = 0; e < 4; ++e) { p0[4 * g + e] = fabsf(pq - (float)(pg_[8 * g + 4 * hi + e] - pq0i)) * U.nsl; p1[4 * g + e] = fabsf(pq - (float)(pg_[32 + 8 * g + 4 * hi + e] - pq0i)) * U.nsl; } } }
    SBAR(); qkt_acc<DQK>(p0, p1, K_lds + st * SHM_K, qr, r32, hi); SBAR();
    const float pmax = rowmax32(p0, p1) + rc;
    if (!__all((pmax - m_reg) * U.C < -150.f)) {
      partialSM_rc(p0, p1, m_reg, mn, al, U.C, U.thr, rc, pmax);
      if (__any(al < 1.f)) { if (hi == 0) al_l[r32] = al; asm volatile("s_waitcnt lgkmcnt(0)" ::: "memory");
#pragma unroll
        for (int d = 0; d < 8; ++d)
#pragma unroll
          for (int r = 0; r < 16; ++r) o[d][r] *= al_l[crow(r, hi)]; }
      finishSM(p0, p1, al, l_reg, pa0, pa1, pa2, pa3); SBAR();
      pv_d0_lean(o, vb0 + st * SHM_V2, pa0, pa1, pa2, pa3); SBAR();
      pv_d0_lean(o + 4, vb0 + st * SHM_V2 + 16384, pa0, pa1, pa2, pa3);
    }
    WAIT_BAR_0();
  }
  if (hi == 0) li_l[r32] = l_reg; asm volatile("s_waitcnt lgkmcnt(0)" ::: "memory");
  { const int le_ = OPQ(lane); const int obase = (wid * QBLK + 4 * (le_ >> 5)) * U.ldo + (le_ & 31);
#pragma unroll
    for (int r = 0; r < 16; ++r) { const int orl = (r & 3) + 8 * (r >> 2); const float rl = __builtin_amdgcn_rcpf(li_l[orl + 4 * hi]); const int ooff = obase + orl * U.ldo;
#pragma unroll
      for (int d0 = 0; d0 < 8; ++d0) U.O[ooff + d0 * 32] = (bf16_t)(cvtpk(o[d0][r] * rl, 0.f) & 0xffffu); } }
#undef DMA_TILE
#undef WAIT_BAR_0
}

template <int MODE>
__device__ __forceinline__ void attn_unit_ml(const AttnUnit& U, char* lds) {
  constexpr int DQK = 128, ND0 = 8, SHM_K = 16384, SHM_V2 = 32768;
  const int wid = __builtin_amdgcn_readfirstlane(U.wid), lane = mk_lane(), tid = wid * 64 + lane, r32 = lane & 31, hi = lane >> 5;
  char* K_lds = lds + A_OFF_K;
  float* ws = (float*)(lds + A_OFF_WS) + wid * 64; float* li_l = ws;
  float* aux = (float*)(lds + A_OFF_AUX);
  const unsigned lds0 = (unsigned)(uintptr_t)lds;
  float l_reg = 0; f32x16 o[8] = {}; bf16x8 qr[ND0];
  { const int qoff = (wid * QBLK + r32) * U.ldq + hi * 8;
#pragma unroll
    for (int d0 = 0; d0 < ND0; ++d0) qr[d0] = *reinterpret_cast<const bf16x8*>(U.Q + (qoff + d0 * 16)); }
  const int qrow = U.q0 + wid * QBLK + r32;
  const float Rr = U.Ag[U.q0] + U.lscale;
  for (int i = tid; i < 4096; i += 512) aux[i] = __builtin_amdgcn_exp2f(Rr - U.Bg[i]);
  const float At = U.Ag[qrow] + U.lscale, Et = U.Eg[qrow];
  const unsigned kdst = lds0 + A_OFF_K + wid * 1024, vdst = lds0 + A_OFF_V + wid * 1024;
  const int vb0 = (int)lds0 + A_OFF_V + v_rd_base(lane);
  const long kstep = (long)KVBLK * U.ldk, vstep = (long)KVBLK * U.ldv;
  const bf16_t* Kt = U.K + (long)U.jt0 * kstep; const bf16_t* Vt = U.V + (long)U.jt0 * vstep;
#define DMA_TILE(t, stg) do { const bf16_t* kp_ = Kt + (long)(t) * kstep; const bf16_t* vp_ = Vt + (long)(t) * vstep; const int tl_ = OPQ(tid) & 511; \
    _Pragma("unroll") for (int i_ = 0; i_ < 2; ++i_) { const int L_ = i_ * 512 + tl_, row_ = L_ >> 4, c_ = (L_ & 15) ^ (row_ & 7); \
      glds16(kp_ + (row_ * U.ldk + c_ * 8), (unsigned)__builtin_amdgcn_readfirstlane(kdst + (stg) * SHM_K + i_ * 8192)); } \
    _Pragma("unroll") for (int i_ = 0; i_ < 2; ++i_) { const int L_ = i_ * 512 + tl_, blk_ = L_ >> 5, kk_ = (blk_ >> 2) * 8 + ((L_ & 31) >> 2), col_ = (blk_ & 3) * 32 + (L_ & 3) * 8; \
      const int k_ = (kk_ & ~0xC) | ((kk_ & 4) << 1) | ((kk_ & 8) >> 1); const bf16_t* vs_ = vp_ + (k_ * U.ldv + col_); \
      glds16(vs_, (unsigned)__builtin_amdgcn_readfirstlane(vdst + (stg) * SHM_V2 + i_ * 8192)); \
      glds16(vs_ + 128, (unsigned)__builtin_amdgcn_readfirstlane(vdst + (stg) * SHM_V2 + 16384 + i_ * 8192)); } } while (0)
#define WAIT_BAR_0() asm volatile("s_waitcnt vmcnt(0) lgkmcnt(0)\n\ts_barrier" ::: "memory")
#define KB(j) ((U.jt0 + (j)) * KVBLK)
#define BAND(j) ((MODE == 2) ? (KB(j) + 63 > U.q0) : (KB(j) < U.q0 + 255))
  f32x16 p0, p1; bf16x8 pa0, pa1, pa2, pa3; const int NT = U.NT;
  DMA_TILE(0, 0);
  WAIT_BAR_0();
  for (int j = 0; j < NT; ++j) {
    const int st = j & 1;
    if (j + 1 < NT) DMA_TILE(j + 1, st ^ 1);
    p0 = f32x16{}; p1 = f32x16{};
    SBAR(); qkt_acc<DQK>(p0, p1, K_lds + st * SHM_K, qr, r32, hi); SBAR();
    partialW2<MODE>(p0, p1, aux + KB(j), BAND(j), qrow - KB(j) - 4 * hi, hi);
    finishW(p0, p1, l_reg, pa0, pa1, pa2, pa3); SBAR();
    pv_d0_lean(o, vb0 + st * SHM_V2, pa0, pa1, pa2, pa3); SBAR();
    pv_d0_lean(o + 4, vb0 + st * SHM_V2 + 16384, pa0, pa1, pa2, pa3);
    WAIT_BAR_0();
  }
  { const float rowf = __builtin_amdgcn_exp2f(At - Rr); const float lfin = fmaxf(fabsf(l_reg) * rowf, Et) * __builtin_amdgcn_rcpf(rowf);
    if (hi == 0) li_l[r32] = lfin; asm volatile("s_waitcnt lgkmcnt(0)" ::: "memory"); }
  { const int le_ = OPQ(lane); const int obase = (wid * QBLK + 4 * (le_ >> 5)) * U.ldo + (le_ & 31);
#pragma unroll
    for (int r = 0; r < 16; ++r) { const int orl = (r & 3) + 8 * (r >> 2); const float rl = __builtin_amdgcn_rcpf(li_l[orl + 4 * hi]); const int ooff = obase + orl * U.ldo;
#pragma unroll
      for (int d0 = 0; d0 < 8; ++d0) U.O[ooff + d0 * 32] = (bf16_t)(cvtpk(o[d0][r] * rl, 0.f) & 0xffffu); } }
#undef DMA_TILE
#undef WAIT_BAR_0
#undef KB
#undef BAND
}
}

#define LAS __attribute__((address_space(3)))
typedef unsigned short bf16_t;
typedef float f32x4 __attribute__((ext_vector_type(4)));
typedef unsigned u32x4 __attribute__((ext_vector_type(4)));
typedef short bf16x8 __attribute__((ext_vector_type(8)));
constexpr int BATCH = 8, SEQ = 4096, T = BATCH * SEQ, DM = 2048, FF = 5632;
constexpr int NPH = 19;
constexpr int LDS_BYTES = 147456;
constexpr float LAM_INIT = 0.35550906759096934f;
constexpr float LOG2E = 1.4426950408889634f;
constexpr size_t MiB = 1u << 20;
constexpr size_t WS_SS = 1009 * MiB, WS_CS = 2 * MiB, WS_MG = 10 * MiB, WS_GA = 12 * MiB, WS_GB = 13 * MiB, WS_GE = 14 * MiB;
constexpr size_t WS_BAR = 15 * MiB, WS_BAR_BYTES = 16384;
constexpr size_t WS_WIN0 = 16 * MiB, WS_WUQ = WS_WIN0 + 17 * MiB, WS_WUKV = WS_WUQ + 2 * MiB, WS_WO0 = WS_WUKV + 2 * MiB, WS_WIN1 = WS_WO0 + 8 * MiB, WS_WO1 = WS_WIN1 + 24 * MiB;
constexpr size_t WS_WGU1 = 77 * MiB, WS_WDN1 = WS_WGU1 + 44 * MiB, WS_XB = 143 * MiB, WS_A = 271 * MiB, WS_B = 655 * MiB, WS_WGU2 = 943 * MiB, WS_WDN2 = WS_WGU2 + 44 * MiB, WS_END = 1012 * MiB;
static_assert(WS_WO1 + 8 * MiB <= WS_WGU1 && WS_WDN1 + 22 * MiB <= WS_XB, "ws map");
__constant__ double INV_FREQ[32] = {1.0, 0.7498942093324559, 0.5623413251903491, 0.4216965034285822, 0.31622776601683794, 0.23713737056616552, 0.1778279410038923, 0.1333521432163324,
    0.1, 0.07498942093324558, 0.05623413251903491, 0.042169650342858224, 0.03162277660168379, 0.023713737056616554, 0.01778279410038923, 0.01333521432163324,
    0.01, 0.007498942093324558, 0.005623413251903491, 0.004216965034285823, 0.0031622776601683794, 0.0023713737056616554, 0.0017782794100389228, 0.001333521432163324,
    0.001, 0.0007498942093324559, 0.0005623413251903491, 0.00042169650342858224, 0.00031622776601683794, 0.00023713737056616554, 0.00017782794100389227, 0.0001333521432163324};

#define XB_TMO      128
#define XB_XCNT(j)  (256  + 64 * (j))
#define XB_XSUB(j)  (1280 + 64 * (j))
#define XB_XGEN(j)  (2304 + 64 * (j))
#define XB_TOP      3328
#define XB_TOPGEN   3392
#define XCD_BAR_WORDS 3456
#define XB_SPIN_CAP (1u << 18)

__device__ __forceinline__ unsigned xb_ld(unsigned* p)              { return __hip_atomic_load(p, __ATOMIC_RELAXED, __HIP_MEMORY_SCOPE_AGENT); }
__device__ __forceinline__ unsigned xb_add(unsigned* p, unsigned v) { return __hip_atomic_fetch_add(p, v, __ATOMIC_RELAXED, __HIP_MEMORY_SCOPE_AGENT); }
__device__ __forceinline__ unsigned xb_xcc_id() { return (unsigned)__builtin_amdgcn_s_getreg((3 << 11) | 20) & 0xFu; }
#define XB_SPIN(cond, bar) do { unsigned _sp = 0; while (cond) { __builtin_amdgcn_s_sleep(1); \
    if ((++_sp & 255u) == 0u) { if (xb_ld(&(bar)[XB_TMO])) break; if (_sp > XB_SPIN_CAP) { atomicAdd(&(bar)[XB_TMO], 1u); break; } } } } while (0)

struct XcdBarrier {
    unsigned* bar; unsigned x; unsigned w;
    volatile LAS unsigned* st;
};

__device__ __forceinline__ XcdBarrier xcd_barrier_post(unsigned* bar, volatile LAS unsigned* st, unsigned wave) {
    XcdBarrier b; b.bar = bar; b.x = xb_xcc_id(); b.st = st; b.w = wave;
    if (wave == 0u && mk_lane() == 0) (void)xb_add(&bar[XB_XCNT(b.x)], 1u);
    return b;
}
__device__ __forceinline__ void xcd_barrier_complete(unsigned* bar, unsigned x, unsigned& nloc, unsigned& nx) {
    const unsigned G = gridDim.x * gridDim.y * gridDim.z;
    unsigned sum, cnt, mine, sp = 0u;
    for (;;) {
        sum = 0u; cnt = 0u; mine = 0u;
#pragma unroll
        for (unsigned j = 0; j < 16; ++j) { const unsigned c = xb_ld(&bar[XB_XCNT(j)]); sum += c; cnt += (c > 0u) ? 1u : 0u; mine = (j == x) ? c : mine; }
        if (sum == G) break;
        __builtin_amdgcn_s_sleep(1);
        if ((++sp & 255u) == 0u) { if (xb_ld(&bar[XB_TMO])) break; if (sp > XB_SPIN_CAP) { atomicAdd(&bar[XB_TMO], 1u); break; } }
    }
    nloc = mine > 0u ? mine : 1u; nx = cnt > 0u ? cnt : 1u;
}

__device__ __forceinline__ void xcd_barrier(const XcdBarrier& b) {
    asm volatile("s_waitcnt vmcnt(0)" ::: "memory");
    __syncthreads();
    if (b.w == 0u && mk_lane() == 0) {
        unsigned* bar = b.bar;
        __builtin_amdgcn_s_waitcnt(0);
        unsigned nloc = b.st[0], nx = b.st[1];
        if (nloc == 0u) { xcd_barrier_complete(bar, b.x, nloc, nx); b.st[0] = nloc; b.st[1] = nx; }
        const unsigned old = xb_add(&bar[XB_XSUB(b.x)], 1u);
        const unsigned gen = old / nloc;
        if (old + 1u == (gen + 1u) * nloc) {
            __builtin_amdgcn_fence(__ATOMIC_RELEASE, "agent");
            asm volatile("s_waitcnt vmcnt(0)" ::: "memory");
            const unsigned og = xb_add(&bar[XB_TOP], 1u);
            const unsigned tg = og / nx;
            if (og + 1u == (tg + 1u) * nx) xb_add(&bar[XB_TOPGEN], 1u);
            else XB_SPIN(xb_ld(&bar[XB_TOPGEN]) == tg, bar);
            __builtin_amdgcn_fence(__ATOMIC_ACQUIRE, "agent");
            xb_add(&bar[XB_XGEN(b.x)], 1u);
            asm volatile("s_waitcnt vmcnt(0)" ::: "memory");
        } else {
            XB_SPIN(xb_ld(&bar[XB_XGEN(b.x)]) == gen, bar);
            __builtin_amdgcn_fence(__ATOMIC_ACQUIRE, "agent");
            asm volatile("s_waitcnt vmcnt(0)" ::: "memory");
        }
    }
    __syncthreads();
}

__device__ __forceinline__ float wave_sum(float v) {
#pragma unroll
    for (int o = 1; o < 64; o <<= 1) v += __shfl_xor(v, o);
    return v;
}
__device__ __forceinline__ float bf2f(short b) { return __uint_as_float(((unsigned)(unsigned short)b) << 16); }
__device__ __forceinline__ unsigned pk2(float lo, float hi) { return pg8::cvt_pk_bf16(lo, hi); }

enum { MAP_ID = 0, MAP_GU = 1, MAP_IN0 = 2, MAP_UQ = 3 };
__device__ __forceinline__ int map_row(int type, int n) {
    if (type == MAP_GU) { if (n < FF) return (n >> 7) * 256 + (n & 127); const int q = n - FF; return (q >> 7) * 256 + 128 + (q & 127); }
    if (type == MAP_IN0) { if (n < 1024) return n; if (n < 1056) return 4096 + (n - 1024); if (n < 1088) return 4096 + 128 + (n - 1056); if (n < 4160) return n - 64; return 4096 + 32 + (n - 4160); }
    if (type == MAP_UQ) { const int h = n / 192, r = n - h * 192; if (r < 128) return h * 128 + r; if (r < 160) return 1024 + 256 * (h >> 2) + (h & 3) * 32 + (r - 128); return 1024 + 256 * (h >> 2) + 128 + (h & 3) * 32 + (r - 160); }
    return n;
}
__device__ __forceinline__ void convert_matrix(const float* W, const float* g, int K, int N, bf16_t* WT, int type, int gw, int NGW, LAS float* scr, int lane) {
    const int nblk = (N + 31) >> 5, nitems = (K >> 6) * nblk;
    const int c4 = (lane & 7) * 4, kr = lane >> 3, c8 = lane & 7;
    f32x4 cur[8], nxt[8];
#define CM_LOAD(dst, it_) do { const int kb_ = (it_) / nblk, nb_ = (it_) - kb_ * nblk, k0_ = kb_ << 6, n0_ = nb_ << 5; const bool ok_ = (it_) < nitems && (n0_ + c4) < N; \
        _Pragma("unroll") for (int i_ = 0; i_ < 8; ++i_) { const int kk_ = kr + 8 * i_; f32x4 v_ = {0.f, 0.f, 0.f, 0.f}; \
            if (ok_) { v_ = *(const f32x4*)(W + (size_t)(k0_ + kk_) * N + n0_ + c4); if (g) v_ = v_ * g[k0_ + kk_]; } dst[i_] = v_; } } while (0)
    int item = gw;
    CM_LOAD(cur, item);
    for (; item < nitems; item += NGW) {
        CM_LOAD(nxt, item + NGW);
        const int kb = item / nblk, nb = item - kb * nblk, k0 = kb << 6, n0 = nb << 5, ncols = (N - n0) < 32 ? (N - n0) : 32;
#pragma unroll
        for (int i = 0; i < 8; ++i) { LAS float* d = scr + (kr + 8 * i) * 33 + c4; d[0] = cur[i].x; d[1] = cur[i].y; d[2] = cur[i].z; d[3] = cur[i].w; }
        asm volatile("s_waitcnt lgkmcnt(0)" ::: "memory");
        const int drow0 = map_row(type, n0);
#pragma unroll
        for (int j = 0; j < 4; ++j) { const int n = kr + 8 * j; const LAS float* s = scr + (8 * c8) * 33 + n;
            u32x4 o; o.x = pk2(s[0 * 33], s[1 * 33]); o.y = pk2(s[2 * 33], s[3 * 33]); o.z = pk2(s[4 * 33], s[5 * 33]); o.w = pk2(s[6 * 33], s[7 * 33]);
            if (n < ncols) *(u32x4*)(WT + (size_t)(drow0 + n) * K + k0 + 8 * c8) = o; }
        asm volatile("s_waitcnt lgkmcnt(0)" ::: "memory");
#pragma unroll
        for (int i = 0; i < 8; ++i) cur[i] = nxt[i];
    }
#undef CM_LOAD
}
__device__ __forceinline__ float logsig(float x) { return fminf(x, 0.f) - log1pf(expf(-fabsf(x))); }

struct Params { const float* in[32]; float* out; unsigned char* ws; int ph_lo, ph_hi; };

__global__ void __launch_bounds__(512, 2) fwd_kernel(Params p) {
    extern __shared__ __attribute__((aligned(16))) unsigned char lds[];
    const int wave = __builtin_amdgcn_readfirstlane((int)threadIdx.x >> 6); const int tid = wave * 64 + mk_lane();
#define lane mk_lane()
    const int G = gridDim.x, bx = blockIdx.x, vcu = (G % 8 == 0) ? (bx % 8) * (G / 8) + bx / 8 : bx;
    const int gw = vcu * 8 + wave, NGW = G * 8;
    const long gtid = (long)vcu * 512 + tid, NGT = (long)G * 512;
    unsigned char* ws = p.ws;
    pg8::ssq_t* SS = (pg8::ssq_t*)(ws + WS_SS);
    float* CS = (float*)(ws + WS_CS); float* MG = (float*)(ws + WS_MG);
    float* GA = (float*)(ws + WS_GA); float* GB = (float*)(ws + WS_GB); float* GE = (float*)(ws + WS_GE);
    bf16_t* W_IN0 = (bf16_t*)(ws + WS_WIN0); bf16_t* W_UQ = (bf16_t*)(ws + WS_WUQ); bf16_t* W_UKV = (bf16_t*)(ws + WS_WUKV); bf16_t* W_O0 = (bf16_t*)(ws + WS_WO0);
    bf16_t* W_IN1 = (bf16_t*)(ws + WS_WIN1); bf16_t* W_O1 = (bf16_t*)(ws + WS_WO1);
    bf16_t* W_GU1 = (bf16_t*)(ws + WS_WGU1); bf16_t* W_DN1 = (bf16_t*)(ws + WS_WDN1); bf16_t* W_GU2 = (bf16_t*)(ws + WS_WGU2); bf16_t* W_DN2 = (bf16_t*)(ws + WS_WDN2);
    bf16_t* XB = (bf16_t*)(ws + WS_XB); bf16_t* HFB = XB;
    bf16_t* RA = (bf16_t*)(ws + WS_A); bf16_t* RB = (bf16_t*)(ws + WS_B);
    bf16_t* Hh = RA;
    bf16_t* Z0 = RA; bf16_t* Qm = RA + (size_t)T * 4096;
    bf16_t* KF = RB; bf16_t* Vm = RB + (size_t)T * 1536; bf16_t* AO = Vm + (size_t)T * 1024;
    bf16_t* QKV1 = RA; bf16_t* O12 = RB; bf16_t* COMB = RA;
    LAS unsigned char* ldsl = (LAS unsigned char*)lds;
    LAS float* scr = (LAS float*)(ldsl + wave * 16384);
#ifndef PHMASK
#define PHMASK 0xFFFFFFu
#endif
#define IN(k) ((((PHMASK) >> (k)) & 1u) && p.ph_lo <= (k) && (k) < p.ph_hi)
#ifndef REPMASK
#define REPMASK 0u
#endif
#define REP(k) for (int rep_ = 0; rep_ <= (int)(((REPMASK) >> (k)) & 1u); ++rep_)
#if MK_N_LAUNCHES == 1
#define SEAM0() do { cg::this_grid().sync(); } while (0)
#define SEAM() do { xcd_barrier(xbar); } while (0)
#else
#define SEAM0() do { } while (0)
#define SEAM() do { } while (0)
#endif
#define FFN_UP(WGU, ssi) do { pg8::Gemm g_{XB, WGU, T, 2 * FF, DM, DM}; pg8::StaticOrder S_; S_.init(T, 2 * FF, G, bx); pg8::EpiSwiglu E_{Hh, SS + (size_t)(ssi) * T}; \
        pg8::gemm_phase<pg8::EpiSwiglu, pg8::StaticOrder, true, true>(ldsl, g_, S_, E_, wave); } while (0)
#define GEMM_RESID(Aop, Kdim, WT, XIN, ssi, ALPHA) do { pg8::Gemm g_{Aop, WT, T, DM, Kdim, Kdim}; pg8::StaticOrder S_; S_.init(T, DM, G, bx); pg8::EpiResid E_{XIN, p.out, XB, SS + (size_t)(ssi) * T, ALPHA}; \
        pg8::gemm_phase<pg8::EpiResid, pg8::StaticOrder, true, true>(ldsl, g_, S_, E_, wave); } while (0)
#define CONVERT_FFN(igu, WGU, WDN) do { convert_matrix(p.in[(igu) + 1], p.in[igu], DM, 2 * FF, WGU, MAP_GU, gw, NGW, scr, lane); convert_matrix(p.in[(igu) + 2], nullptr, FF, DM, WDN, MAP_ID, gw, NGW, scr, lane); } while (0)

#if MK_N_LAUNCHES == 1
    if (tid < 2) ((LAS unsigned*)(ldsl + LDS_BYTES - 64))[tid] = 0u;
    __syncthreads();
    XcdBarrier xbar = xcd_barrier_post((unsigned*)(ws + WS_BAR), (volatile LAS unsigned*)(ldsl + LDS_BYTES - 64), (unsigned)wave);
#endif
    if (IN(0)) REP(0) {
        for (long i = gtid; i < 8L * T; i += NGT) SS[T + i] = 0ull;
        { const float* x = p.in[0];
          for (int row = gw; row < T; row += NGW) { const f32x4* xr = (const f32x4*)(x + (size_t)row * DM) + lane; float s = 0.f; unsigned long long* o8 = (unsigned long long*)(XB + (size_t)row * DM) + lane;
#pragma unroll
            for (int j = 0; j < 8; ++j) { const f32x4 v = xr[64 * j]; s += (v.x * v.x + v.y * v.y) + (v.z * v.z + v.w * v.w); o8[64 * j] = (unsigned long long)pk2(v.x, v.y) | ((unsigned long long)pk2(v.z, v.w) << 32); }
            s = wave_sum(s); if (lane == 0) SS[row] = (pg8::ssq_t)(s * 16777216.0f); } }
        { const int* pos = (const int*)p.in[1];
          for (long i = gtid; i < 32L * T; i += NGT) { const int t = (int)(i >> 5), k = (int)(i & 31); const double rev = (double)pos[t] * INV_FREQ[k] * 0.15915494309189535; const float fr = (float)(rev - rint(rev));
            CS[(size_t)t * 64 + k] = __builtin_amdgcn_cosf(fr); CS[(size_t)t * 64 + 32 + k] = __builtin_amdgcn_sinf(fr); } }
        for (long i = gtid; i < 176L * 256; i += NGT) { const int r = (int)(i >> 8), c = (int)(i & 255); const int row = 4096 + (r < 80 ? 48 + r : 160 + (r - 80)); *(u32x4*)(W_IN0 + (size_t)row * DM + c * 8) = (u32x4){0u, 0u, 0u, 0u}; }
        convert_matrix(p.in[6], p.in[5], DM, 4176, W_IN0, MAP_IN0, gw, NGW, scr, lane);
        convert_matrix(p.in[8], p.in[7], 512, 1536, W_UQ, MAP_UQ, gw, NGW, scr, lane);
        convert_matrix(p.in[10], p.in[9], 512, 2048, W_UKV, MAP_ID, gw, NGW, scr, lane);
        convert_matrix(p.in[13], nullptr, DM, DM, W_O0, MAP_ID, gw, NGW, scr, lane);
        convert_matrix(p.in[21], p.in[20], DM, 6144, W_IN1, MAP_ID, gw, NGW, scr, lane);
        convert_matrix(p.in[27], nullptr, DM, DM, W_O1, MAP_ID, gw, NGW, scr, lane);
        CONVERT_FFN(2, W_GU1, W_DN1);
    }
    SEAM0();
    if (IN(1)) REP(1) FFN_UP(W_GU1, 0);
    SEAM();
    if (IN(2)) GEMM_RESID(Hh, FF, W_DN1, p.in[0], 1, 0.5f);
    SEAM();
    if (IN(3)) { pg8::Gemm g_{XB, W_IN0, T, 4352, DM, DM}; pg8::StaticOrder S_; S_.init(T, 4352, G, bx);
        pg8::EpiIn0 E_{Z0, KF, MG, SS + (size_t)1 * T, SS + (size_t)7 * T, SS + (size_t)8 * T, CS, p.in[11]};
        pg8::gemm_phase<pg8::EpiIn0, pg8::StaticOrder, true, true>(ldsl, g_, S_, E_, wave); }
    SEAM();
    if (IN(4)) REP(4) {
        { pg8::Gemm g_{Z0, W_UQ, T, 1536, 512, 4096}; pg8::StaticOrder S_; S_.init(T, 1536, G, bx); pg8::EpiUq E_{Qm, SS + (size_t)7 * T, CS};
          pg8::gemm_phase<pg8::EpiUq, pg8::StaticOrder, true, true>(ldsl, g_, S_, E_, wave); }
        { pg8::Gemm g_{Z0 + 512, W_UKV, T, 2048, 512, 4096}; pg8::StaticOrder S_; S_.init(T, 2048, G, bx); pg8::EpiUkv E_{KF, Vm, SS + (size_t)8 * T};
          pg8::gemm_phase<pg8::EpiUkv, pg8::StaticOrder, true, true>(ldsl, g_, S_, E_, wave); }
        if ((gw & 31) == 0) for (int c = gw >> 5; c < 64; c += (NGW >> 5)) {
            const int dir = c >> 5, bh = c & 31, b = bh >> 2, h = bh & 3; const float* mg = MG + (size_t)b * SEQ * 16; const int ci = (dir ? 8 : 0) + h, cf = (dir ? 12 : 4) + h;
            float Fseg = 0.f, Mseg = -INFINITY;
            for (int u0 = 0; u0 < 64; u0 += 16) { float li[16], gf[16];
#pragma unroll
                for (int u = 0; u < 16; ++u) { const int up = lane * 64 + u0 + u, t = dir ? (SEQ - 1 - up) : up; li[u] = mg[t * 16 + ci]; gf[u] = mg[t * 16 + cf]; }
#pragma unroll
                for (int u = 0; u < 16; ++u) { const float lf = logsig(gf[u]); Fseg += lf; Mseg = fmaxf(Mseg + lf, li[u]); } }
            float runF = 0.f, runM = -1e30f, myF = 0.f, myM = 0.f;
            for (int i = 0; i < 64; ++i) { const float Fi = __shfl(Fseg, i), Mi = __shfl(Mseg, i); if (lane == i) { myF = runF; myM = runM; } runF += Fi; runM = fmaxf(runM + Fi, Mi); }
            float F = myF, m = myM; float* ga = GA + (size_t)c * SEQ; float* gb = GB + (size_t)c * SEQ; float* ge = GE + (size_t)c * SEQ;
            for (int u0 = 0; u0 < 64; u0 += 16) { float li[16], gf[16];
#pragma unroll
                for (int u = 0; u < 16; ++u) { const int up = lane * 64 + u0 + u, t = dir ? (SEQ - 1 - up) : up; li[u] = mg[t * 16 + ci]; gf[u] = mg[t * 16 + cf]; }
#pragma unroll
                for (int u = 0; u < 16; ++u) { const int up = lane * 64 + u0 + u, t = dir ? (SEQ - 1 - up) : up; const float lf = logsig(gf[u]); F += lf; m = fmaxf(m + lf, li[u]);
                    ga[t] = (F - m) * LOG2E; gb[t] = (F - li[u]) * LOG2E; ge[t] = expf(-m); } }
        }
        CONVERT_FFN(14, W_GU1, W_DN1);
    }
    SEAM();
    if (IN(5)) REP(5) {
#ifndef P5SEL
#define P5SEL 3
#endif
        if (P5SEL & 1) for (int it = vcu; it < 1024; it += G) {
            att::AttnUnit U{};
            const int qb = it & 15, bh = it >> 4, b = bh >> 3, h = bh & 7; const size_t r0 = (size_t)b * SEQ;
            U.Q = Qm + (r0 + qb * 256) * 1536 + h * 192; U.K = KF + r0 * 1536 + h * 192; U.V = Vm + r0 * 1024 + h * 128; U.O = AO + (r0 + qb * 256) * 2048 + h * 128;
            U.ldq = 1536; U.ldk = 1536; U.ldv = 1024; U.ldo = 2048; U.jt0 = 0; U.NT = 64; U.q0 = qb * 256;
            U.C = 0.07216878364870322f * LOG2E; U.thr = 8.0f / 0.07216878364870322f;
            U.wid = wave; att::attn_unit_dma<192, 0>(U, (char*)lds);
        }
        if (P5SEL & 2) for (int i2 = vcu; i2 < 1024; i2 += G) {
            att::AttnUnit U{};
            const int dir = i2 >> 9, i3 = i2 & 511, qb = i3 & 15, bh = i3 >> 4, b = bh >> 2, h = bh & 3; const size_t r0 = (size_t)b * SEQ;
            U.Q = Z0 + (r0 + qb * 256) * 4096 + 1024 + h * 128; U.K = Z0 + r0 * 4096 + 1536 + h * 128; U.V = Z0 + r0 * 4096 + 2048 + h * 256;
            U.ldq = 4096; U.ldk = 4096; U.ldv = 4096; U.ldo = 1024; U.q0 = qb * 256; U.lscale = -3.5f;
            const int ch = dir * 32 + bh;
            U.Ag = GA + (size_t)ch * SEQ; U.Bg = GB + (size_t)ch * SEQ; U.Eg = GE + (size_t)ch * SEQ;
            U.O = HFB + (size_t)dir * T * 1024 + (r0 + qb * 256) * 1024 + h * 256;
            U.wid = wave; if (dir == 0) { U.jt0 = 0; U.NT = 4 * (qb + 1); att::attn_unit_ml<2>(U, (char*)lds); }
            else { U.jt0 = 4 * qb; U.NT = 64 - 4 * qb; att::attn_unit_ml<3>(U, (char*)lds); }
        }
    }
    SEAM();
    if (IN(6)) {
        const float* gm = p.in[12];
        for (int row = gw; row < T; row += NGW) {
            const bf16x8* hf = (const bf16x8*)(HFB + (size_t)row * 1024 + lane * 16); const bf16x8* hb = (const bf16x8*)(HFB + (size_t)T * 1024 + (size_t)row * 1024 + lane * 16);
            const bf16x8* mo = (const bf16x8*)(Z0 + (size_t)row * 4096 + 3072 + lane * 16);
            float hm[16]; float sq = 0.f;
#pragma unroll
            for (int j = 0; j < 2; ++j) { const bf16x8 a = hf[j], b = hb[j];
#pragma unroll
                for (int e = 0; e < 8; ++e) { const float v = bf2f(a[e]) + bf2f(b[e]); hm[8 * j + e] = v; sq += v * v; } }
            sq += __shfl_xor(sq, 1); sq += __shfl_xor(sq, 2); sq += __shfl_xor(sq, 4); sq += __shfl_xor(sq, 8);
            const float rs = __builtin_amdgcn_rsqf(sq * (1.0f / 256.0f) + 1e-6f);
#pragma unroll
            for (int j = 0; j < 2; ++j) { const bf16x8 mv = mo[j]; const f32x4 g0 = *(const f32x4*)(gm + lane * 16 + 8 * j), g1 = *(const f32x4*)(gm + lane * 16 + 8 * j + 4); float y[8];
#pragma unroll
                for (int e = 0; e < 8; ++e) { const float gg = e < 4 ? g0[e] : g1[e - 4]; const float sg = __builtin_amdgcn_rcpf(1.0f + __builtin_amdgcn_exp2f(-LOG2E * bf2f(mv[e]))); y[e] = hm[8 * j + e] * rs * gg * sg; }
                u32x4 w; w.x = pk2(y[0], y[1]); w.y = pk2(y[2], y[3]); w.z = pk2(y[4], y[5]); w.w = pk2(y[6], y[7]);
                *(u32x4*)(AO + (size_t)row * 2048 + 1024 + lane * 16 + 8 * j) = w; }
        }
        CONVERT_FFN(17, W_GU2, W_DN2);
    }
    SEAM();
    if (IN(7)) GEMM_RESID(AO, DM, W_O0, p.out, 2, 1.0f);
    SEAM();
    if (IN(8)) FFN_UP(W_GU1, 2);
    SEAM();
    if (IN(9)) GEMM_RESID(Hh, FF, W_DN1, p.out, 3, 0.5f);
    SEAM();
    if (IN(10)) FFN_UP(W_GU2, 3);
    SEAM();
    if (IN(11)) GEMM_RESID(Hh, FF, W_DN2, p.out, 4, 0.5f);
    SEAM();
    if (IN(12)) { { pg8::Gemm g_{XB, W_IN1, T, 6144, DM, DM}; pg8::StaticOrder S_; S_.init(T, 6144, G, bx); pg8::EpiScaled E_{QKV1, 6144, SS + (size_t)4 * T, 1.0f / 2048.0f};
          pg8::gemm_phase<pg8::EpiScaled, pg8::StaticOrder, true, true>(ldsl, g_, S_, E_, wave); }
        CONVERT_FFN(28, W_GU1, W_DN1); }
    SEAM();
    if (IN(13)) REP(13) {
        const int* pos = (const int*)p.in[1];
        for (int it = vcu; it < 2048; it += G) {
            const int q_ = it & 15, mp = (it >> 4) & 1, b = (it >> 5) & 7, h = it >> 8, qb = (q_ + ((h < 4) ? ((0x084C >> (4 * h)) & 15) : 0)) & 15; const size_t r0 = (size_t)b * SEQ;
            att::AttnUnit U{};
            U.Q = QKV1 + (r0 + qb * 256) * 6144 + h * 256 + mp * 128; U.K = QKV1 + r0 * 6144 + 2048 + h * 256 + mp * 128; U.V = QKV1 + r0 * 6144 + 4096 + h * 256;
            U.O = O12 + (r0 + qb * 256) * 4096 + h * 512 + mp * 256;
            U.ldq = 6144; U.ldk = 6144; U.ldv = 6144; U.ldo = 4096; U.jt0 = 0; U.NT = 64; U.q0 = qb * 256;
            U.C = 0.08838834764831845f * LOG2E; U.thr = 8.0f / 0.08838834764831845f; U.posg = pos + r0; U.nsl = -exp2f(-(float)(h + 1)) * 11.313708498984761f;
            U.wid = wave; att::attn_unit_da(U, (char*)lds);
        }
    }
    SEAM();
    if (IN(14)) {
        float l1 = p.in[22][lane] * p.in[23][lane] + p.in[22][lane + 64] * p.in[23][lane + 64], l2 = p.in[24][lane] * p.in[25][lane] + p.in[24][lane + 64] * p.in[25][lane + 64];
        l1 = wave_sum(l1); l2 = wave_sum(l2); const float lam = expf(l1) - expf(l2) + LAM_INIT;
        const float* gs = p.in[26]; const int head = lane >> 3, e0 = (lane & 7) * 32;
        for (int row = gw; row < T; row += NGW) {
            const bf16x8* o1 = (const bf16x8*)(O12 + (size_t)row * 4096 + head * 512 + e0); const bf16x8* o2 = (const bf16x8*)(O12 + (size_t)row * 4096 + head * 512 + 256 + e0);
            float d[32]; float sq = 0.f;
#pragma unroll
            for (int j = 0; j < 4; ++j) { const bf16x8 a = o1[j], b = o2[j];
#pragma unroll
                for (int e = 0; e < 8; ++e) { const float v = bf2f(a[e]) - lam * bf2f(b[e]); d[8 * j + e] = v; sq += v * v; } }
            sq += __shfl_xor(sq, 1); sq += __shfl_xor(sq, 2); sq += __shfl_xor(sq, 4);
            const float rs = __builtin_amdgcn_rsqf(sq * (1.0f / 256.0f) + 1e-6f) * (1.0f - LAM_INIT);
#pragma unroll
            for (int j = 0; j < 4; ++j) { const f32x4 g0 = *(const f32x4*)(gs + e0 + 8 * j), g1 = *(const f32x4*)(gs + e0 + 8 * j + 4); u32x4 w;
                w.x = pk2(d[8 * j + 0] * rs * g0[0], d[8 * j + 1] * rs * g0[1]); w.y = pk2(d[8 * j + 2] * rs * g0[2], d[8 * j + 3] * rs * g0[3]);
                w.z = pk2(d[8 * j + 4] * rs * g1[0], d[8 * j + 5] * rs * g1[1]); w.w = pk2(d[8 * j + 6] * rs * g1[2], d[8 * j + 7] * rs * g1[3]);
                *(u32x4*)(COMB + (size_t)row * 2048 + head * 256 + e0 + 8 * j) = w; }
        }
    }
    SEAM();
    if (IN(15)) GEMM_RESID(COMB, DM, W_O1, p.out, 5, 1.0f);
    SEAM();
    if (IN(16)) FFN_UP(W_GU1, 5);
    SEAM();
    if (IN(17)) { pg8::Gemm g_{Hh, W_DN1, T, DM, FF, FF}; pg8::StaticOrder S_; S_.init(T, DM, G, bx); pg8::EpiResidT<false> E_{p.out, p.out, XB, SS + (size_t)6 * T, 0.5f};
        pg8::gemm_phase<pg8::EpiResidT<false>, pg8::StaticOrder, true, true>(ldsl, g_, S_, E_, wave); }
    SEAM();
    if (IN(18)) { const float* gf = p.in[31];
        for (int row = gw; row < T; row += NGW) { f32x4* xr = (f32x4*)(p.out + (size_t)row * DM) + lane; const float rs = pg8::rstd_of(SS[(size_t)6 * T + row], 1.0f / 2048.0f);
#pragma unroll
            for (int j = 0; j < 8; ++j) { const f32x4 g = ((const f32x4*)gf)[64 * j + lane]; xr[64 * j] = xr[64 * j] * rs * g; } } }
#undef IN
#undef lane
}

extern "C" void kernel_launch(void* const* d_in, const int* in_sizes, int n_in, void* d_out, int out_size, void* d_ws, size_t ws_size, hipStream_t stream) {
    static int grid = 0;
    if (grid == 0) {
        if (n_in != 32 || out_size != T * DM || ws_size < WS_END) { fprintf(stderr, "kernel_launch: unexpected shapes: n_in %d out %d ws %zu (need >= %zu)\n", n_in, out_size, ws_size, (size_t)WS_END); grid = -1; return; }
        int dev = 0, cus = 0, per_cu = 0;
        hipGetDevice(&dev); hipDeviceGetAttribute(&cus, hipDeviceAttributeMultiprocessorCount, dev);
        if (hipFuncSetAttribute((const void*)fwd_kernel, hipFuncAttributeMaxDynamicSharedMemorySize, LDS_BYTES) != hipSuccess) { fprintf(stderr, "kernel_launch: hipFuncSetAttribute failed\n"); grid = -1; return; }
        if (hipOccupancyMaxActiveBlocksPerMultiprocessor(&per_cu, (const void*)fwd_kernel, 512, LDS_BYTES) != hipSuccess || per_cu < 1) { fprintf(stderr, "kernel_launch: occupancy query says %d\n", per_cu); per_cu = 1; }
        (void)hipGetLastError();
        grid = cus * 1;
    }
    if (grid < 0) return;
    Params a{};
    for (int i = 0; i < 32; ++i) a.in[i] = (const float*)d_in[i];
    a.out = (float*)d_out; a.ws = (unsigned char*)d_ws;
#if MK_N_LAUNCHES == 1
    a.ph_lo = 0; a.ph_hi = NPH;
    if (hipMemsetAsync((char*)d_ws + WS_BAR, 0, WS_BAR_BYTES, stream) != hipSuccess) { fprintf(stderr, "kernel_launch: memset of barrier words failed\n"); return; }
    void* args[] = {&a};
    hipError_t e = hipLaunchCooperativeKernel((const void*)fwd_kernel, dim3(grid), dim3(512), args, LDS_BYTES, stream);
    if (e != hipSuccess) fprintf(stderr, "kernel_launch: cooperative launch failed: %s (grid %d)\n", hipGetErrorString(e), grid);
#else
    for (int k = 0; k < NPH; ++k) { a.ph_lo = k; a.ph_hi = k + 1; hipLaunchKernelGGL(fwd_kernel, dim3(grid), dim3(512), LDS_BYTES, stream, a); }
#endif
}
```

```cpp
#include <hip/hip_runtime.h>
#include <hip/hip_cooperative_groups.h>
#include <cstdio>
#include <cstdint>
#include <cmath>
namespace cg = cooperative_groups;
__device__ __forceinline__ int mk_lane() { int l; asm volatile("v_mbcnt_lo_u32_b32 %0, -1, 0\n\tv_mbcnt_hi_u32_b32 %0, -1, %0" : "=v"(l)); return l; }
#ifndef MK_N_LAUNCHES
#define MK_N_LAUNCHES 1
#endif
namespace pg8 {
#define PG8_LAS __attribute__((address_space(3)))
typedef unsigned short bf16_t;
typedef short bf16x8 __attribute__((ext_vector_type(8)));
typedef float f32x4 __attribute__((ext_vector_type(4)));
typedef unsigned u32x4 __attribute__((ext_vector_type(4)));
constexpr int BM = 256, BK = 64, HALF = 128, HTB = HALF * BK * 2  , STAGE_BYTES = 8 * HTB, NXCD = 8, WGM = 8;

__host__ __device__ __forceinline__ int lds_byte(int r, int c) { const int st = (r >> 4) * 2 + (c >> 5), rr = r & 15, cc = c & 31, ob = rr * 64 + cc * 2; return st * 1024 + (ob ^ (((ob >> 9) & 1) << 5)); }
__host__ __device__ __forceinline__ void stage_rc(int b, int& R, int& C) { const int st = b / 1024, sb = b % 1024, swz = sb ^ (((sb >> 9) & 1) << 5); R = (st >> 1) * 16 + swz / 64; C = (st & 1) * 32 + (swz % 64) / 2; }
__host__ __device__ __forceinline__ int perm32(int rho) { const int n = rho >> 4, i = rho & 15; return 8 * (i >> 2) + 4 * n + (i & 3); }

struct Unit { int pm, pn; };
struct Gemm { const bf16_t* A; const bf16_t* Bt; int M, N, K, lda; };

struct StaticOrder {
    int nM, nN, nwg, G, c;
    __host__ __device__ void init(int M, int N, int G_, int c_) { nM = M / BM; nN = N / BM; nwg = nM * nN; G = G_; c = c_; }
    __host__ __device__ bool next(int i, Unit& u) const {
        const long L = (long)i * G + c; if (L >= nwg) return false;
        int wgid = (int)L; { const int q = nwg / NXCD, r = nwg % NXCD, xcd = wgid % NXCD, off = wgid / NXCD; wgid = (xcd < r ? xcd * (q + 1) : r * (q + 1) + (xcd - r) * q) + off; }
        const int nig = WGM * nN, gid = wgid / nig, fm = gid * WGM, gsz = (nM - fm) < WGM ? (nM - fm) : WGM;
        u.pm = fm + ((wgid % nig) % gsz); u.pn = (wgid % nig) / gsz; return true;
    }
    __device__ __forceinline__ void a_ready(const Unit&) const {}
    __device__ __forceinline__ void done(const Unit&) const {}
};

typedef float f32x2_t __attribute__((ext_vector_type(2))); typedef __bf16 bf16x2_t __attribute__((ext_vector_type(2)));
__device__ __forceinline__ unsigned cvt_pk_bf16(float lo, float hi) { f32x2_t v = {lo, hi}; bf16x2_t b = __builtin_convertvector(v, bf16x2_t); return __builtin_bit_cast(unsigned, b); }
__device__ __forceinline__ u32x4 pack8(const f32x4 a, const f32x4 b) { u32x4 w; w.x = cvt_pk_bf16(a[0], a[1]); w.y = cvt_pk_bf16(a[2], a[3]); w.z = cvt_pk_bf16(b[0], b[1]); w.w = cvt_pk_bf16(b[2], b[3]); return w; }
typedef unsigned long long ssq_t;
__device__ __forceinline__ float rstd_of(ssq_t ss, float inv_n) { return __builtin_amdgcn_rsqf((float)ss * (1.0f / 16777216.0f) * inv_n + 1e-6f); }
__device__ __forceinline__ void ss_add(ssq_t* p, float sq) { __hip_atomic_fetch_add(p, (ssq_t)(sq * 16777216.0f), __ATOMIC_RELAXED, __HIP_MEMORY_SCOPE_AGENT); }
__device__ __forceinline__ float silu_mul(float g, float u) { return g * u * __builtin_amdgcn_rcpf(1.0f + __builtin_amdgcn_exp2f(-1.4426950408889634f * g)); }
__device__ __forceinline__ float silu_mul2(float g, float u, float c1, float c2) { return (g * u) * (c2 * __builtin_amdgcn_rcpf(1.0f + __builtin_amdgcn_exp2f(g * c1))); }
__device__ __forceinline__ float dot4(const f32x4 a) { return (a[0] * a[0] + a[1] * a[1]) + (a[2] * a[2] + a[3] * a[3]); }

struct EpiSwiglu {
    static constexpr bool PERM = true, AFTER_DRAIN = false;
    bf16_t* H; const ssq_t* ss;
    __device__ __forceinline__ void operator()(const f32x4 (&acc)[2][2][4][2], const Unit& u, int wr, int wc, int fr, int fq) const {
        const int row0 = u.pm * BM + wr * 64 + fr, col0 = u.pn * 128 + wc * 32 + 8 * fq;
#pragma unroll
        for (int ai = 0; ai < 2; ++ai)
#pragma unroll
            for (int m = 0; m < 4; ++m) { const int row = row0 + ai * HALF + m * 16; const float rs = rstd_of(ss[row], 1.0f / 2048.0f);
                const float c1 = -1.4426950408889634f * rs, c2 = rs * rs;
                f32x4 a0, a1;
#pragma unroll
                for (int e = 0; e < 4; ++e) { a0[e] = silu_mul2(acc[ai][0][m][0][e], acc[ai][1][m][0][e], c1, c2); a1[e] = silu_mul2(acc[ai][0][m][1][e], acc[ai][1][m][1][e], c1, c2); }
                *(u32x4*)(H + (size_t)row * 5632 + col0) = pack8(a0, a1); }
    }
};
template <bool WRITE_XB = true> struct EpiResidT {
    static constexpr bool PERM = true, AFTER_DRAIN = false;
    const float* xin; float* xout; bf16_t* xb; ssq_t* ssout; float alpha;
    __device__ __forceinline__ void operator()(const f32x4 (&acc)[2][2][4][2], const Unit& u, int wr, int wc, int fr, int fq) const {
        const int row0 = u.pm * BM + wr * 64 + fr, col0 = u.pn * BM + wc * 32 + 8 * fq;
#pragma unroll
        for (int ai = 0; ai < 2; ++ai)
#pragma unroll
            for (int m = 0; m < 4; ++m) { const int row = row0 + ai * HALF + m * 16; const size_t off = (size_t)row * 2048 + col0; float sq = 0.f;
#pragma unroll
                for (int bj = 0; bj < 2; ++bj) {
                    const f32x4 x0 = __builtin_nontemporal_load((const f32x4*)(xin + off + bj * HALF)), x1 = __builtin_nontemporal_load((const f32x4*)(xin + off + bj * HALF + 4));
                    const f32x4 v0 = x0 + acc[ai][bj][m][0] * alpha, v1 = x1 + acc[ai][bj][m][1] * alpha;
                    __builtin_nontemporal_store(v0, (f32x4*)(xout + off + bj * HALF)); __builtin_nontemporal_store(v1, (f32x4*)(xout + off + bj * HALF + 4));
                    if (WRITE_XB) *(u32x4*)(xb + off + bj * HALF) = pack8(v0, v1); sq += dot4(v0) + dot4(v1); }
                sq += __shfl_xor(sq, 16); sq += __shfl_xor(sq, 32);
                if (fq == 0) ss_add(ssout + row, sq); }
    }
};
typedef EpiResidT<true> EpiResid;
struct EpiScaled {
    static constexpr bool PERM = true, AFTER_DRAIN = false;
    bf16_t* O; int ldc; const ssq_t* ss; float inv_n;
    __device__ __forceinline__ void operator()(const f32x4 (&acc)[2][2][4][2], const Unit& u, int wr, int wc, int fr, int fq) const {
        const int row0 = u.pm * BM + wr * 64 + fr, col0 = u.pn * BM + wc * 32 + 8 * fq;
#pragma unroll
        for (int ai = 0; ai < 2; ++ai)
#pragma unroll
            for (int m = 0; m < 4; ++m) { const int row = row0 + ai * HALF + m * 16; const float rs = rstd_of(ss[row], inv_n);
#pragma unroll
                for (int bj = 0; bj < 2; ++bj) *(u32x4*)(O + (size_t)row * ldc + col0 + bj * HALF) = pack8(acc[ai][bj][m][0] * rs, acc[ai][bj][m][1] * rs); }
    }
};
__device__ __forceinline__ void rope8(const f32x4 x1a, const f32x4 x1b, const f32x4 x2a, const f32x4 x2b, const float* cs, int i0, u32x4& w1, u32x4& w2) {
    const f32x4 c0 = *(const f32x4*)(cs + i0), c1 = *(const f32x4*)(cs + i0 + 4), s0 = *(const f32x4*)(cs + 32 + i0), s1 = *(const f32x4*)(cs + 36 + i0);
    w1 = pack8(x1a * c0 - x2a * s0, x1b * c1 - x2b * s1); w2 = pack8(x2a * c0 + x1a * s0, x2b * c1 + x1b * s1);
}
struct EpiIn0 {
    static constexpr bool PERM = true, AFTER_DRAIN = false;
    bf16_t* Z0; bf16_t* KF; float* MG; const ssq_t* ss; ssq_t* ss_cq; ssq_t* ss_ckv; const float* CS; const float* bg;
    __device__ __forceinline__ void operator()(const f32x4 (&acc)[2][2][4][2], const Unit& u, int wr, int wc, int fr, int fq) const {
        const int row0 = u.pm * BM + wr * 64 + fr;
        if (u.pn < 16) {
            const int col0 = u.pn * BM + wc * 32 + 8 * fq;
#pragma unroll
            for (int ai = 0; ai < 2; ++ai)
#pragma unroll
                for (int m = 0; m < 4; ++m) { const int row = row0 + ai * HALF + m * 16; const float rs = rstd_of(ss[row], 1.0f / 2048.0f); float sq = 0.f;
#pragma unroll
                    for (int bj = 0; bj < 2; ++bj) { const f32x4 v0 = acc[ai][bj][m][0] * rs, v1 = acc[ai][bj][m][1] * rs;
                        *(u32x4*)(Z0 + (size_t)row * 4096 + col0 + bj * HALF) = pack8(v0, v1); sq += dot4(v0) + dot4(v1); }
                    if (u.pn < 4) { sq += __shfl_xor(sq, 16); sq += __shfl_xor(sq, 32); if (fq == 0) ss_add((u.pn < 2 ? ss_cq : ss_ckv) + row, sq); } }
        } else if (wc == 0) {
#pragma unroll
            for (int ai = 0; ai < 2; ++ai)
#pragma unroll
                for (int m = 0; m < 4; ++m) { const int row = row0 + ai * HALF + m * 16; const float rs = rstd_of(ss[row], 1.0f / 2048.0f);
                    u32x4 w1, w2; rope8(acc[ai][0][m][0] * rs, acc[ai][0][m][1] * rs, acc[ai][1][m][0] * rs, acc[ai][1][m][1] * rs, CS + (size_t)row * 64, 8 * fq, w1, w2);
                    bf16_t* kp = KF + (size_t)row * 1536 + 128 + 8 * fq;
#pragma unroll
                    for (int h = 0; h < 8; ++h) { *(u32x4*)(kp + h * 192) = w1; *(u32x4*)(kp + h * 192 + 32) = w2; } }
        } else if (wc == 1 && fq < 2) {
            const f32x4 b0 = *(const f32x4*)(bg + 8 * fq), b1 = *(const f32x4*)(bg + 8 * fq + 4);
#pragma unroll
            for (int ai = 0; ai < 2; ++ai)
#pragma unroll
                for (int m = 0; m < 4; ++m) { const int row = row0 + ai * HALF + m * 16; const float rs = rstd_of(ss[row], 1.0f / 2048.0f);
                    *(f32x4*)(MG + (size_t)row * 16 + 8 * fq) = acc[ai][0][m][0] * rs + b0; *(f32x4*)(MG + (size_t)row * 16 + 8 * fq + 4) = acc[ai][0][m][1] * rs + b1; }
        }
    }
};
struct EpiUq {
    static constexpr bool PERM = true, AFTER_DRAIN = false;
    bf16_t* Q; const ssq_t* ss_cq; const float* CS;
    __device__ __forceinline__ void operator()(const f32x4 (&acc)[2][2][4][2], const Unit& u, int wr, int wc, int fr, int fq) const {
        const int row0 = u.pm * BM + wr * 64 + fr;
#pragma unroll
        for (int ai = 0; ai < 2; ++ai)
#pragma unroll
            for (int m = 0; m < 4; ++m) { const int row = row0 + ai * HALF + m * 16; const float rs = rstd_of(ss_cq[row], 1.0f / 512.0f);
                if (u.pn < 4) {
#pragma unroll
                    for (int bj = 0; bj < 2; ++bj) *(u32x4*)(Q + (size_t)row * 1536 + (2 * u.pn + bj) * 192 + wc * 32 + 8 * fq) = pack8(acc[ai][bj][m][0] * rs, acc[ai][bj][m][1] * rs);
                } else {
                    u32x4 w1, w2; rope8(acc[ai][0][m][0] * rs, acc[ai][0][m][1] * rs, acc[ai][1][m][0] * rs, acc[ai][1][m][1] * rs, CS + (size_t)row * 64, 8 * fq, w1, w2);
                    bf16_t* qp = Q + (size_t)row * 1536 + (4 * (u.pn - 4) + wc) * 192 + 128 + 8 * fq; *(u32x4*)qp = w1; *(u32x4*)(qp + 32) = w2;
                } }
    }
};
struct EpiUkv {
    static constexpr bool PERM = true, AFTER_DRAIN = false;
    bf16_t* KF; bf16_t* V; const ssq_t* ss_ckv;
    __device__ __forceinline__ void operator()(const f32x4 (&acc)[2][2][4][2], const Unit& u, int wr, int wc, int fr, int fq) const {
        const int row0 = u.pm * BM + wr * 64 + fr;
#pragma unroll
        for (int ai = 0; ai < 2; ++ai)
#pragma unroll
            for (int m = 0; m < 4; ++m) { const int row = row0 + ai * HALF + m * 16; const float rs = rstd_of(ss_ckv[row], 1.0f / 512.0f);
                *(u32x4*)(KF + (size_t)row * 1536 + u.pn * 192 + wc * 32 + 8 * fq) = pack8(acc[ai][0][m][0] * rs, acc[ai][0][m][1] * rs);
                *(u32x4*)(V + (size_t)row * 1024 + u.pn * 128 + wc * 32 + 8 * fq) = pack8(acc[ai][1][m][0] * rs, acc[ai][1][m][1] * rs); }
    }
};

template <class Epi, class Sched, bool ALIGN_EPI = false, bool SP2 = false>
__device__ __forceinline__ void gemm_phase(PG8_LAS unsigned char* lds, const Gemm g, const Sched& S, const Epi& E, const int wave_in) {
    const int wid = __builtin_amdgcn_readfirstlane(wave_in), lane = mk_lane(), tid = wid * 64 + lane, wr = wid >> 2, wc = wid & 3, fr = lane & 15, fq = lane >> 4;
    const int K = g.K, nt = K / BK;
    unsigned voffA[2], voffB[2];
#pragma unroll
    for (int i = 0; i < 2; ++i) { int R, C; stage_rc(tid * 16 + i * 8192, R, C); const int Rb = Epi::PERM ? ((R & ~31) + perm32(R & 31)) : R;
        voffA[i] = (unsigned)(R * g.lda + C) * 2u; voffB[i] = (unsigned)(Rb * K + C) * 2u; }
    const size_t kstep = (size_t)(BK * 2);
    const size_t hstep = (size_t)HALF * K * 2, hstepA = (size_t)HALF * g.lda * 2;
    const size_t tstep = 2 * hstep, tstepA = 2 * hstepA;
    const unsigned ldsw = (unsigned)wid * 1024u;
    const int aoff = lds_byte(wr * 64 + fr, fq * 8), boff = lds_byte(wc * 32 + fr, fq * 8);
#define PG8_SA(b, h) (((b) * 2 + (h)) * HTB)
#define PG8_SB(b, h) ((4 + (b) * 2 + (h)) * HTB)
#define PG8_STAGE(bufoff, gbase, voff) do { _Pragma("unroll") for (int _i = 0; _i < 2; ++_i) \
        __builtin_amdgcn_global_load_lds((const unsigned*)((const char*)(gbase) + (voff)[_i]), (PG8_LAS unsigned*)(lds + (bufoff) + ldsw + _i * 8192), 16, 0, 0); } while (0)
#define PG8_LDA(dst, b, h) do { _Pragma("unroll") for (int m = 0; m < 4; ++m) _Pragma("unroll") for (int k = 0; k < 2; ++k) dst[m][k] = *(const PG8_LAS bf16x8*)(lds + PG8_SA(b, h) + aoff + m * 2048 + k * 1024); } while (0)
#define PG8_LDB(dst, b, h) do { _Pragma("unroll") for (int n = 0; n < 2; ++n) _Pragma("unroll") for (int k = 0; k < 2; ++k) dst[n][k] = *(const PG8_LAS bf16x8*)(lds + PG8_SB(b, h) + boff + n * 2048 + k * 1024); } while (0)
#define PG8_MMA(ai, bj, At, Bt) do { __builtin_amdgcn_s_setprio(1); _Pragma("unroll") for (int m = 0; m < 4; ++m) _Pragma("unroll") for (int n = 0; n < 2; ++n) _Pragma("unroll") for (int k = 0; k < 2; ++k) \
        acc[ai][bj][m][n] = __builtin_amdgcn_mfma_f32_16x16x32_bf16(Bt[n][k], At[m][k], acc[ai][bj][m][n], 0, 0, 0); __builtin_amdgcn_s_setprio(0); } while (0)
#define PG8_WAIT_V(n) asm volatile("s_waitcnt vmcnt(" #n ")" ::: "memory")
#define PG8_WAIT_L(n) asm volatile("s_waitcnt lgkmcnt(" #n ")" ::: "memory")
#define PG8_BAR __builtin_amdgcn_s_barrier()
#define PG8_SCHED __builtin_amdgcn_sched_barrier(0)
    Unit cur, nxt; int ui = 0;
    if (!S.next(0, cur)) return;
    f32x4 acc[2][2][4][2];
#pragma unroll
    for (int a = 0; a < 2; ++a)
#pragma unroll
        for (int b = 0; b < 2; ++b)
#pragma unroll
            for (int m = 0; m < 4; ++m)
#pragma unroll
                for (int n = 0; n < 2; ++n) acc[a][b][m][n] = (f32x4){0.f, 0.f, 0.f, 0.f};
    bf16x8 At[4][2], B0[2][2], B1[2][2];
    const char* cA = (const char*)g.A + (size_t)cur.pm * tstepA; const char* cB = (const char*)g.Bt + (size_t)cur.pn * tstep;
    S.a_ready(cur);
    if constexpr (SP2) {
        PG8_STAGE(PG8_SB(0, 0), cB, voffB); PG8_STAGE(PG8_SB(0, 1), cB + hstep, voffB); PG8_STAGE(PG8_SA(0, 0), cA, voffA); PG8_STAGE(PG8_SA(0, 1), cA + hstepA, voffA);
        if (wr == 1) PG8_BAR;
        PG8_WAIT_V(2); PG8_BAR;
        PG8_STAGE(PG8_SB(1, 0), cB + kstep, voffB); PG8_STAGE(PG8_SA(1, 0), cA + kstep, voffA); PG8_STAGE(PG8_SB(1, 1), cB + hstep + kstep, voffB);
        PG8_WAIT_V(6); PG8_BAR;
    } else {
        PG8_STAGE(PG8_SB(0, 0), cB, voffB); PG8_STAGE(PG8_SA(0, 0), cA, voffA); PG8_STAGE(PG8_SB(0, 1), cB + hstep, voffB); PG8_STAGE(PG8_SA(0, 1), cA + hstepA, voffA);
        if (wr == 1) PG8_BAR;
        PG8_WAIT_V(4); PG8_BAR;
        PG8_STAGE(PG8_SB(1, 0), cB + kstep, voffB); PG8_STAGE(PG8_SA(1, 0), cA + kstep, voffA); PG8_STAGE(PG8_SB(1, 1), cB + hstep + kstep, voffB);
        PG8_WAIT_V(6); PG8_BAR;
    }
    for (;;) {
        const bool has_next = S.next(ui + 1, nxt);
        const char* nA = has_next ? (const char*)g.A + (size_t)nxt.pm * tstepA : cA; const char* nB = has_next ? (const char*)g.Bt + (size_t)nxt.pn * tstep : cB;
        for (int t = 0; t < nt; t += 2) {
            const bool last = (t == nt - 2);
            const char* a1 = cA + (size_t)(t + 1) * kstep;
            const char* a2 = last ? nA : cA + (size_t)(t + 2) * kstep; const char* b2 = last ? nB : cB + (size_t)(t + 2) * kstep;
            const char* a3 = a2 + kstep; const char* b3 = b2 + kstep;
            if (last && has_next) S.a_ready(nxt);
            if constexpr (SP2) {
            PG8_LDB(B0, 0, 0); PG8_LDB(B1, 0, 1); PG8_SCHED; PG8_LDA(At, 0, 0); PG8_STAGE(PG8_SA(1, 1), a1 + hstepA, voffA);
            PG8_WAIT_V(8); PG8_WAIT_L(0); PG8_BAR; PG8_MMA(0, 0, At, B0); PG8_MMA(0, 1, At, B1); PG8_BAR; PG8_SCHED;
            PG8_LDA(At, 0, 1); PG8_STAGE(PG8_SB(0, 0), b2, voffB); PG8_STAGE(PG8_SB(0, 1), b2 + hstep, voffB); PG8_STAGE(PG8_SA(0, 0), a2, voffA);
            PG8_WAIT_V(8); PG8_WAIT_L(0); PG8_BAR; PG8_MMA(1, 0, At, B0); PG8_MMA(1, 1, At, B1); PG8_BAR; PG8_SCHED;
            PG8_LDB(B0, 1, 0); PG8_LDB(B1, 1, 1); PG8_SCHED; PG8_LDA(At, 1, 0); PG8_STAGE(PG8_SA(0, 1), a2 + hstepA, voffA);
            PG8_WAIT_V(8); PG8_WAIT_L(0); PG8_BAR; PG8_MMA(0, 0, At, B0); PG8_MMA(0, 1, At, B1); PG8_BAR; PG8_SCHED;
            PG8_LDA(At, 1, 1); PG8_STAGE(PG8_SB(1, 0), b3, voffB); PG8_STAGE(PG8_SB(1, 1), b3 + hstep, voffB); PG8_STAGE(PG8_SA(1, 0), a3, voffA);
            PG8_WAIT_V(8); PG8_WAIT_L(0); PG8_BAR; PG8_MMA(1, 0, At, B0); PG8_MMA(1, 1, At, B1); PG8_BAR; PG8_SCHED;
            } else {
            PG8_LDB(B0, 0, 0); PG8_SCHED; PG8_LDA(At, 0, 0); PG8_STAGE(PG8_SA(1, 1), a1 + hstepA, voffA);
            PG8_WAIT_L(8); PG8_BAR; PG8_WAIT_L(0); PG8_MMA(0, 0, At, B0); PG8_BAR; PG8_SCHED;
            PG8_LDB(B1, 0, 1); PG8_STAGE(PG8_SB(0, 0), b2, voffB);
            PG8_BAR; PG8_WAIT_L(0); PG8_MMA(0, 1, At, B1); PG8_BAR;
            PG8_LDA(At, 0, 1); PG8_STAGE(PG8_SA(0, 0), a2, voffA);
            PG8_BAR; PG8_WAIT_L(0); PG8_MMA(1, 0, At, B0); PG8_BAR; PG8_SCHED;
            PG8_STAGE(PG8_SB(0, 1), b2 + hstep, voffB);
            PG8_WAIT_V(6); PG8_BAR; PG8_MMA(1, 1, At, B1); PG8_BAR;
            PG8_LDB(B0, 1, 0); PG8_SCHED; PG8_LDA(At, 1, 0); PG8_STAGE(PG8_SA(0, 1), a2 + hstepA, voffA);
            PG8_WAIT_L(8); PG8_BAR; PG8_WAIT_L(0); PG8_MMA(0, 0, At, B0); PG8_BAR; PG8_SCHED;
            PG8_LDB(B1, 1, 1); PG8_STAGE(PG8_SB(1, 0), b3, voffB);
            PG8_BAR; PG8_WAIT_L(0); PG8_MMA(0, 1, At, B1); PG8_BAR;
            PG8_LDA(At, 1, 1); PG8_STAGE(PG8_SA(1, 0), a3, voffA);
            PG8_BAR; PG8_WAIT_L(0); PG8_MMA(1, 0, At, B0); PG8_BAR; PG8_SCHED;
            PG8_STAGE(PG8_SB(1, 1), b3 + hstep, voffB);
            PG8_WAIT_V(6); PG8_BAR; PG8_MMA(1, 1, At, B1); PG8_BAR;
            }
        }
        if constexpr (ALIGN_EPI) { if (wr == 0) PG8_BAR; }
        if constexpr (!Epi::AFTER_DRAIN) { E(acc, cur, wr, wc, fr, fq); S.done(cur); }
        if (!has_next) break;
#pragma unroll
        for (int a = 0; a < 2; ++a)
#pragma unroll
            for (int b = 0; b < 2; ++b)
#pragma unroll
                for (int m = 0; m < 4; ++m)
#pragma unroll
                    for (int n = 0; n < 2; ++n) acc[a][b][m][n] = (f32x4){0.f, 0.f, 0.f, 0.f};
        cur = nxt; cA = nA; cB = nB; ++ui;
        if constexpr (ALIGN_EPI) { if (wr == 1) PG8_BAR; }
    }
    PG8_WAIT_V(0);
    if constexpr (!ALIGN_EPI) { if (wr == 0) PG8_BAR; }
    PG8_BAR;
    if constexpr (Epi::AFTER_DRAIN) { E.fused(acc, cur, wr, wc, fr, fq, lds, wid, lane); S.done(cur); }
#undef PG8_SA
#undef PG8_SB
#undef PG8_STAGE
#undef PG8_LDA
#undef PG8_LDB
#undef PG8_MMA
#undef PG8_WAIT_V
#undef PG8_WAIT_L
#undef PG8_BAR
#undef PG8_SCHED
}
}

namespace att {
typedef unsigned short bf16_t;
using bf16x8 = __attribute__((ext_vector_type(8))) short;
using s16x4  = __attribute__((ext_vector_type(4))) short;
using f32x16 = __attribute__((ext_vector_type(16))) float;
using f32x4  = __attribute__((ext_vector_type(4))) float;
using u32x4  = __attribute__((ext_vector_type(4))) unsigned;
constexpr int NW = 8, QBLK = 32, KVBLK = 64;
constexpr int SHM_V = 16384, SHM_KMAX = 64 * 192 * 2;
constexpr int OFF_V = 0, OFF_K = 2 * SHM_V, OFF_WS = OFF_K + 2 * SHM_KMAX, OFF_AUX = OFF_WS + NW * 64 * 4, LDS_ATT = OFF_AUX + 4096 * 4;
#define SBAR() __builtin_amdgcn_sched_barrier(0)
__device__ __forceinline__ int crow(int r, int hi) { return (r & 3) + 8 * (r >> 2) + 4 * hi; }
typedef float f32x2_t __attribute__((ext_vector_type(2))); typedef __bf16 bf16x2_t __attribute__((ext_vector_type(2)));
__device__ __forceinline__ unsigned cvtpk(float lo, float hi) { f32x2_t v = {lo, hi}; bf16x2_t b = __builtin_convertvector(v, bf16x2_t); return __builtin_bit_cast(unsigned, b); }
__device__ __forceinline__ int v_st(int k, int c) { const int kk = (k & ~0xC) | ((k & 4) << 1) | ((k & 8) >> 1); return ((kk >> 3) * 4 + (c >> 5)) * 512 + ((kk & 7) * 32 + (c & 31)) * 2; }
__device__ __forceinline__ int v_rd_base(int lane) { return ((lane & 3) << 3) | (((lane >> 2) & 3) << 6) | (((lane >> 4) & 1) << 5) | (((lane >> 5) & 1) << 8); }
constexpr int v_rd_off(int d0, int ks, int half) { return d0 * 512 + ks * 4096 + half * 2048; }
template <int OFF> __device__ __forceinline__ s16x4 tr_read(int vb) { s16x4 r; asm volatile("ds_read_b64_tr_b16 %0, %1 offset:%2" : "=&v"(r) : "v"(vb), "i"(OFF) : "memory"); return r; }
template <int D0> __device__ __forceinline__ void pv_one(f32x16& od, int vb, bf16x8 pa0, bf16x8 pa1, bf16x8 pa2, bf16x8 pa3) {
  const s16x4 l0 = tr_read<v_rd_off(D0, 0, 0)>(vb), h0 = tr_read<v_rd_off(D0, 0, 1)>(vb), l1 = tr_read<v_rd_off(D0, 1, 0)>(vb), h1 = tr_read<v_rd_off(D0, 1, 1)>(vb);
  const s16x4 l2 = tr_read<v_rd_off(D0, 2, 0)>(vb), h2 = tr_read<v_rd_off(D0, 2, 1)>(vb), l3 = tr_read<v_rd_off(D0, 3, 0)>(vb), h3 = tr_read<v_rd_off(D0, 3, 1)>(vb);
  asm volatile("s_waitcnt lgkmcnt(0)" ::: "memory"); SBAR();
#define PK(L, H) (bf16x8){L[0], L[1], L[2], L[3], H[0], H[1], H[2], H[3]}
  od = __builtin_amdgcn_mfma_f32_32x32x16_bf16(pa0, PK(l0, h0), od, 0, 0, 0);
  od = __builtin_amdgcn_mfma_f32_32x32x16_bf16(pa1, PK(l1, h1), od, 0, 0, 0);
  od = __builtin_amdgcn_mfma_f32_32x32x16_bf16(pa2, PK(l2, h2), od, 0, 0, 0);
  od = __builtin_amdgcn_mfma_f32_32x32x16_bf16(pa3, PK(l3, h3), od, 0, 0, 0);
#undef PK
}
__device__ __forceinline__ void pv_d0(f32x16* o, int vb, bf16x8 pa0, bf16x8 pa1, bf16x8 pa2, bf16x8 pa3) {
  pv_one<0>(o[0], vb, pa0, pa1, pa2, pa3); pv_one<1>(o[1], vb, pa0, pa1, pa2, pa3); pv_one<2>(o[2], vb, pa0, pa1, pa2, pa3); pv_one<3>(o[3], vb, pa0, pa1, pa2, pa3);
}
#define PK4(P, BASE, OUT) do { unsigned a0 = cvtpk(P[BASE + 0], P[BASE + 1]), a1 = cvtpk(P[BASE + 2], P[BASE + 3]);   \
    unsigned b0 = cvtpk(P[BASE + 4], P[BASE + 5]), b1 = cvtpk(P[BASE + 6], P[BASE + 7]);                              \
    auto r0 = __builtin_amdgcn_permlane32_swap(a0, b0, false, false); auto r1 = __builtin_amdgcn_permlane32_swap(a1, b1, false, false); \
    u32x4 w = {r0[0], r1[0], r0[1], r1[1]}; OUT = *reinterpret_cast<bf16x8*>(&w); } while (0)

struct AttnUnit {
  const bf16_t* Q; const bf16_t* K; const bf16_t* V; bf16_t* O;
  int ldq, ldk, ldv, ldo;
  int jt0, NT, q0, wid;
  float C, thr;
  const int* posg; float nsl;
  const float* Ag; const float* Bg; const float* Eg; float lscale;
};

template <int MODE> __device__ __forceinline__ void partialSM(f32x16& p0, f32x16& p1, float& m_reg, float& mn, float& alpha, float C, float thr, const float* auxk, float pq, float nsl, int hi) {
  if (MODE == 1) {
#pragma unroll
    for (int g = 0; g < 4; ++g) { const f32x4 a = *(const f32x4*)(auxk + 8 * g + 4 * hi), b = *(const f32x4*)(auxk + 32 + 8 * g + 4 * hi);
#pragma unroll
      for (int e = 0; e < 4; ++e) { p0[4 * g + e] = fmaf(fabsf(pq - a[e]), nsl, p0[4 * g + e]); p1[4 * g + e] = fmaf(fabsf(pq - b[e]), nsl, p1[4 * g + e]); } }
  }
  float pmax = p0[0];
#pragma unroll
  for (int r = 1; r < 16; ++r) pmax = fmaxf(pmax, p0[r]);
#pragma unroll
  for (int r = 0; r < 16; ++r) pmax = fmaxf(pmax, p1[r]);
  { auto rr = __builtin_amdgcn_permlane32_swap(__float_as_uint(pmax), __float_as_uint(pmax), false, false);
    pmax = fmaxf(__uint_as_float(rr[0]), __uint_as_float(rr[1])); }
  if (__builtin_expect(__all(pmax - m_reg <= thr), 1)) { mn = m_reg; alpha = 1.f; }
  else { mn = fmaxf(m_reg, pmax); alpha = __builtin_amdgcn_exp2f((m_reg - mn) * C); m_reg = mn; }
  const float mnC = -mn * C;
#pragma unroll
  for (int r = 0; r < 16; ++r) p0[r] = fmaf(p0[r], C, mnC);
#pragma unroll
  for (int r = 0; r < 16; ++r) p1[r] = fmaf(p1[r], C, mnC);
#pragma unroll
  for (int r = 0; r < 16; ++r) p0[r] = __builtin_amdgcn_exp2f(p0[r]);
}
__device__ __forceinline__ void finishSM(f32x16& p0, f32x16& p1, float alpha, float& l_reg, bf16x8& pa0, bf16x8& pa1, bf16x8& pa2, bf16x8& pa3) {
#pragma unroll
  for (int r = 0; r < 16; ++r) p1[r] = __builtin_amdgcn_exp2f(p1[r]);
  float ps = 0;
#pragma unroll
  for (int r = 0; r < 16; ++r) ps += p0[r];
#pragma unroll
  for (int r = 0; r < 16; ++r) ps += p1[r];
  { auto rr = __builtin_amdgcn_permlane32_swap(__float_as_uint(ps), __float_as_uint(ps), false, false);
    ps = __uint_as_float(rr[0]) + __uint_as_float(rr[1]); }
  l_reg = l_reg * alpha + ps;
  PK4(p0, 0, pa0); PK4(p0, 8, pa1); PK4(p1, 0, pa2); PK4(p1, 8, pa3);
}
template <int MODE> __device__ __forceinline__ void partialW(f32x16& p0, f32x16& p1, const float* auxk, float At, bool band, int qrel, int hi) {
#pragma unroll
  for (int g = 0; g < 4; ++g) { const f32x4 a = *(const f32x4*)(auxk + 8 * g + 4 * hi), b = *(const f32x4*)(auxk + 32 + 8 * g + 4 * hi);
#pragma unroll
    for (int e = 0; e < 4; ++e) { p0[4 * g + e] *= __builtin_amdgcn_exp2f(At - a[e]); p1[4 * g + e] *= __builtin_amdgcn_exp2f(At - b[e]); } }
  if (band) {
#pragma unroll
    for (int r = 0; r < 16; ++r) { const int kvl = (r & 3) + 8 * (r >> 2);
      const bool k0 = (MODE == 2) ? (kvl <= qrel) : (kvl >= qrel), k1 = (MODE == 2) ? (kvl + 32 <= qrel) : (kvl + 32 >= qrel);
      p0[r] = k0 ? p0[r] : 0.f; p1[r] = k1 ? p1[r] : 0.f; }
  }
}
template <int MODE> __device__ __forceinline__ void partialW2(f32x16& p0, f32x16& p1, const float* auxk, bool band, int qrel, int hi) {
#pragma unroll
  for (int g = 0; g < 4; ++g) { const f32x4 a = *(const f32x4*)(auxk + 8 * g + 4 * hi), b = *(const f32x4*)(auxk + 32 + 8 * g + 4 * hi);
#pragma unroll
    for (int e = 0; e < 4; ++e) { p0[4 * g + e] *= a[e]; p1[4 * g + e] *= b[e]; } }
  if (band) {
#pragma unroll
    for (int r = 0; r < 16; ++r) { const int kvl = (r & 3) + 8 * (r >> 2);
      const bool k0 = (MODE == 2) ? (kvl <= qrel) : (kvl >= qrel), k1 = (MODE == 2) ? (kvl + 32 <= qrel) : (kvl + 32 >= qrel);
      p0[r] = k0 ? p0[r] : 0.f; p1[r] = k1 ? p1[r] : 0.f; }
  }
}
__device__ __forceinline__ void finishW(f32x16& p0, f32x16& p1, float& l_reg, bf16x8& pa0, bf16x8& pa1, bf16x8& pa2, bf16x8& pa3) {
  float ps = 0;
#pragma unroll
  for (int r = 0; r < 16; ++r) ps += p0[r];
#pragma unroll
  for (int r = 0; r < 16; ++r) ps += p1[r];
  { auto rr = __builtin_amdgcn_permlane32_swap(__float_as_uint(ps), __float_as_uint(ps), false, false);
    ps = __uint_as_float(rr[0]) + __uint_as_float(rr[1]); }
  l_reg += ps;
  PK4(p0, 0, pa0); PK4(p0, 8, pa1); PK4(p1, 0, pa2); PK4(p1, 8, pa3);
}
template <int DQK, bool BIAS = false> __device__ __forceinline__ void qkt(f32x16& p0, f32x16& p1, const char* Ks, const bf16x8* qr, int r32, int hi, const float* auxk = nullptr, float pq = 0.f, float nsl = 0.f) {
  constexpr int ROWB = DQK * 2;
  if (BIAS) {
#pragma unroll
    for (int g = 0; g < 4; ++g) { const f32x4 a = *(const f32x4*)(auxk + 8 * g + 4 * hi), b = *(const f32x4*)(auxk + 32 + 8 * g + 4 * hi);
#pragma unroll
      for (int e = 0; e < 4; ++e) { p0[4 * g + e] = fabsf(pq - a[e]) * nsl; p1[4 * g + e] = fabsf(pq - b[e]) * nsl; } }
  } else { p0 = f32x16{}; p1 = f32x16{}; }
  const int sw = (r32 & 7) << 4; const char* k0p = Ks + r32 * ROWB; const char* k1p = Ks + (32 + r32) * ROWB;
#pragma unroll
  for (int d0 = 0; d0 < DQK / 16; ++d0) { const int cb = ((d0 * 16 + hi * 8) * 2) ^ sw;
    const bf16x8 b0 = *reinterpret_cast<const bf16x8*>(k0p + cb);
    const bf16x8 b1 = *reinterpret_cast<const bf16x8*>(k1p + cb);
    p0 = __builtin_amdgcn_mfma_f32_32x32x16_bf16(b0, qr[d0], p0, 0, 0, 0);
    p1 = __builtin_amdgcn_mfma_f32_32x32x16_bf16(b1, qr[d0], p1, 0, 0, 0); }
}

#define OPQ(x) ({ int t_ = (x); asm volatile("" : "+v"(t_)); t_; })
__device__ __forceinline__ void glds16(const void* gsrc, unsigned lds_dst) { unsigned keep;
  asm volatile("s_mov_b32 %0, m0\n\ts_mov_b32 m0, %2\n\ts_nop 0\n\tglobal_load_lds_dwordx4 %1, off\n\ts_mov_b32 m0, %0" : "=&s"(keep) : "v"(gsrc), "s"(lds_dst) : "memory"); }
constexpr int R_OFF_V = 0, R_OFF_K = 3 * SHM_V, R_OFF_WS = R_OFF_K + 3 * SHM_KMAX, R_OFF_AUX = R_OFF_WS + NW * 64 * 4, R_LDS = R_OFF_AUX + 4096 * 4;
template <int DQK, int MODE>
__device__ __forceinline__ void attn_unit_dma(const AttnUnit& U, char* lds) {
  constexpr int ND0 = DQK / 16, CPR = DQK / 8, NKC = (64 * CPR) / 512, SHM_K = 64 * DQK * 2, NPT = NKC + 2;
  constexpr int PM = (MODE == 1) ? 0 : MODE;
  const int wid = __builtin_amdgcn_readfirstlane(U.wid), lane = mk_lane(), tid = wid * 64 + lane, r32 = lane & 31, hi = lane >> 5;
  char* V_lds = lds + R_OFF_V; char* K_lds = lds + R_OFF_K;
  float* ws = (float*)(lds + R_OFF_WS) + wid * 64; float* li_l = ws; float* al_l = ws + 32;
  float* aux = (float*)(lds + R_OFF_AUX);
  const unsigned lds0 = (unsigned)(uintptr_t)lds;
  float m_reg = -1e30f, l_reg = 0; f32x16 o[4] = {}; bf16x8 qr[ND0];
  { const int qoff = (wid * QBLK + r32) * U.ldq + hi * 8;
#pragma unroll
    for (int d0 = 0; d0 < ND0; ++d0) qr[d0] = *reinterpret_cast<const bf16x8*>(U.Q + (qoff + d0 * 16)); }
  const int qrow = U.q0 + wid * QBLK + r32;
  float pq = 0.f, At = 0.f, Et = 0.f;
  if (MODE == 1) { for (int i = tid; i < 4096; i += 512) aux[i] = (float)U.posg[i]; pq = (float)U.posg[qrow]; }
  if (MODE >= 2) { for (int i = tid; i < 4096; i += 512) aux[i] = U.Bg[i]; At = U.Ag[qrow] + U.lscale; Et = U.Eg[qrow]; }
  int ksrc[NKC], vsrc[2];
#pragma unroll
  for (int i = 0; i < NKC; ++i) { const int L = i * 512 + wid * 64 + lane, row = L / CPR, cs = L - row * CPR, c = cs ^ (row & 7); ksrc[i] = row * U.ldk + c * 8; }
#pragma unroll
  for (int i = 0; i < 2; ++i) { const int L = i * 512 + wid * 64 + lane, blk = L >> 5, kk = (blk >> 2) * 8 + ((L & 31) >> 2), col = (blk & 3) * 32 + (L & 3) * 8;
    const int k = (kk & ~0xC) | ((kk & 4) << 1) | ((kk & 8) >> 1); vsrc[i] = k * U.ldv + col; }
  const unsigned kdst = lds0 + R_OFF_K + wid * 1024, vdst = lds0 + R_OFF_V + wid * 1024;
  const int vb0 = (int)lds0 + R_OFF_V + v_rd_base(lane);
  const bf16_t* Kt = U.K + (long)U.jt0 * KVBLK * U.ldk; const bf16_t* Vt = U.V + (long)U.jt0 * KVBLK * U.ldv;
  const long kstep = (long)KVBLK * U.ldk, vstep = (long)KVBLK * U.ldv;
#define DMA_TILE(t, stg) do { const bf16_t* kp_ = Kt + (long)(t) * kstep; const bf16_t* vp_ = Vt + (long)(t) * vstep; \
    _Pragma("unroll") for (int i_ = 0; i_ < NKC; ++i_) glds16(kp_ + ksrc[i_], (unsigned)__builtin_amdgcn_readfirstlane(kdst + (stg) * SHM_K + i_ * 8192)); \
    _Pragma("unroll") for (int i_ = 0; i_ < 2; ++i_) glds16(vp_ + vsrc[i_], (unsigned)__builtin_amdgcn_readfirstlane(vdst + (stg) * SHM_V + i_ * 8192)); } while (0)
#define WAIT_BAR_N() asm volatile("s_waitcnt vmcnt(%0) lgkmcnt(0)\n\ts_barrier" :: "n"(NPT) : "memory")
#define WAIT_BAR_0() asm volatile("s_waitcnt vmcnt(0) lgkmcnt(0)\n\ts_barrier" ::: "memory")
#define RESC(a) do { if (MODE < 2) { if (__any((a) < 1.f)) { if (hi == 0) al_l[r32] = (a); asm volatile("s_waitcnt lgkmcnt(0)" ::: "memory"); \
    _Pragma("unroll") for (int d = 0; d < 4; ++d) _Pragma("unroll") for (int r = 0; r < 16; ++r) o[d][r] *= al_l[crow(r, hi)]; } } } while (0)
#define KB(j) ((U.jt0 + (j)) * KVBLK)
#define BAND(j) ((MODE == 2) ? (KB(j) + 63 > U.q0) : (KB(j) < U.q0 + 255))
#define PARTIAL(P0, P1, j, MN, AL) do { if (MODE < 2) partialSM<PM>(P0, P1, m_reg, MN, AL, U.C, U.thr, aux, 0.f, 0.f, hi); \
    else partialW<MODE>(P0, P1, aux + KB(j), At, BAND(j), qrow - KB(j) - 4 * hi, hi); } while (0)
#define FINISH(P0, P1, AL) do { if (MODE < 2) finishSM(P0, P1, AL, l_reg, pa0, pa1, pa2, pa3); else finishW(P0, P1, l_reg, pa0, pa1, pa2, pa3); } while (0)
  f32x16 pA0, pA1; float mnA = 0.f, alA = 1.f; bf16x8 pa0, pa1, pa2, pa3; const int NT = U.NT;
  DMA_TILE(0, 0); DMA_TILE(1, 1);
  WAIT_BAR_N();
  int st = 0, st2 = 2;
  for (int j = 0; j < NT; ++j) {
    if (j + 2 < NT) DMA_TILE(j + 2, st2);
    SBAR(); qkt<DQK, MODE == 1>(pA0, pA1, K_lds + st * SHM_K, qr, r32, hi, aux + KB(j), pq, U.nsl); SBAR();
    PARTIAL(pA0, pA1, j, mnA, alA);
    RESC(alA);
    FINISH(pA0, pA1, alA); SBAR();
    pv_d0(o, vb0 + st * SHM_V, pa0, pa1, pa2, pa3);
    if (j + 2 < NT) WAIT_BAR_N(); else WAIT_BAR_0();
    st = (st == 2) ? 0 : st + 1; st2 = (st2 == 2) ? 0 : st2 + 1;
  }
  { const float lfin = (MODE < 2) ? l_reg : fmaxf(fabsf(l_reg), Et);
    if (hi == 0) li_l[r32] = lfin; asm volatile("s_waitcnt lgkmcnt(0)" ::: "memory"); }
  { const int obase = (wid * QBLK + 4 * hi) * U.ldo + r32;
#pragma unroll
    for (int r = 0; r < 16; ++r) { const int orl = (r & 3) + 8 * (r >> 2); const float rl = __builtin_amdgcn_rcpf(li_l[orl + 4 * hi]); const int ooff = obase + orl * U.ldo;
#pragma unroll
      for (int d0 = 0; d0 < 4; ++d0) U.O[ooff + d0 * 32] = (bf16_t)(cvtpk(o[d0][r] * rl, 0.f) & 0xffffu); } }
#undef DMA_TILE
#undef WAIT_BAR_N
#undef WAIT_BAR_0
#undef RESC
#undef KB
#undef BAND
#undef PARTIAL
#undef FINISH
}

template <int DQK> __device__ __forceinline__ void qkt_acc(f32x16& p0, f32x16& p1, const char* Ks, const bf16x8* qr, int r32, int hi) {
  constexpr int ROWB = DQK * 2;
  const int sw = (r32 & 7) << 4; const char* k0p = Ks + r32 * ROWB; const char* k1p = Ks + (32 + r32) * ROWB;
#pragma unroll
  for (int d0 = 0; d0 < DQK / 16; ++d0) { const int cb = ((d0 * 16 + hi * 8) * 2) ^ sw;
    const bf16x8 b0 = *reinterpret_cast<const bf16x8*>(k0p + cb);
    const bf16x8 b1 = *reinterpret_cast<const bf16x8*>(k1p + cb);
    p0 = __builtin_amdgcn_mfma_f32_32x32x16_bf16(b0, qr[d0], p0, 0, 0, 0);
    p1 = __builtin_amdgcn_mfma_f32_32x32x16_bf16(b1, qr[d0], p1, 0, 0, 0); }
}
__device__ __forceinline__ float rowmax32(const f32x16& p0, const f32x16& p1) {
  float pmax = p0[0];
#pragma unroll
  for (int r = 1; r < 16; ++r) pmax = fmaxf(pmax, p0[r]);
#pragma unroll
  for (int r = 0; r < 16; ++r) pmax = fmaxf(pmax, p1[r]);
  auto rr = __builtin_amdgcn_permlane32_swap(__float_as_uint(pmax), __float_as_uint(pmax), false, false);
  return fmaxf(__uint_as_float(rr[0]), __uint_as_float(rr[1]));
}
__device__ __forceinline__ void partialSM_rc(f32x16& p0, f32x16& p1, float& m_reg, float& mn, float& alpha, float C, float thr, float rc, float pmax) {
  if (__builtin_expect(__all(pmax - m_reg <= thr), 1)) { mn = m_reg; alpha = 1.f; }
  else { mn = fmaxf(m_reg, pmax); alpha = __builtin_amdgcn_exp2f((m_reg - mn) * C); m_reg = mn; }
  const float mnC = (rc - mn) * C;
#pragma unroll
  for (int r = 0; r < 16; ++r) p0[r] = fmaf(p0[r], C, mnC);
#pragma unroll
  for (int r = 0; r < 16; ++r) p1[r] = fmaf(p1[r], C, mnC);
#pragma unroll
  for (int r = 0; r < 16; ++r) p0[r] = __builtin_amdgcn_exp2f(p0[r]);
}
template <int D0> __device__ __forceinline__ void pv_one_lean(f32x16& od, int vb, bf16x8 pa0, bf16x8 pa1, bf16x8 pa2, bf16x8 pa3) {
#define PKL(L, H) (bf16x8){L[0], L[1], L[2], L[3], H[0], H[1], H[2], H[3]}
  { const s16x4 l0 = tr_read<v_rd_off(D0, 0, 0)>(vb), h0 = tr_read<v_rd_off(D0, 0, 1)>(vb), l1 = tr_read<v_rd_off(D0, 1, 0)>(vb), h1 = tr_read<v_rd_off(D0, 1, 1)>(vb);
    asm volatile("s_waitcnt lgkmcnt(0)" ::: "memory"); SBAR();
    od = __builtin_amdgcn_mfma_f32_32x32x16_bf16(pa0, PKL(l0, h0), od, 0, 0, 0); od = __builtin_amdgcn_mfma_f32_32x32x16_bf16(pa1, PKL(l1, h1), od, 0, 0, 0); }
  SBAR();
  { const s16x4 l2 = tr_read<v_rd_off(D0, 2, 0)>(vb), h2 = tr_read<v_rd_off(D0, 2, 1)>(vb), l3 = tr_read<v_rd_off(D0, 3, 0)>(vb), h3 = tr_read<v_rd_off(D0, 3, 1)>(vb);
    asm volatile("s_waitcnt lgkmcnt(0)" ::: "memory"); SBAR();
    od = __builtin_amdgcn_mfma_f32_32x32x16_bf16(pa2, PKL(l2, h2), od, 0, 0, 0); od = __builtin_amdgcn_mfma_f32_32x32x16_bf16(pa3, PKL(l3, h3), od, 0, 0, 0); }
#undef PKL
}
__device__ __forceinline__ void pv_d0_lean(f32x16* o, int vb, bf16x8 pa0, bf16x8 pa1, bf16x8 pa2, bf16x8 pa3) {
  pv_one_lean<0>(o[0], vb, pa0, pa1, pa2, pa3); SBAR(); pv_one_lean<1>(o[1], vb, pa0, pa1, pa2, pa3); SBAR(); pv_one_lean<2>(o[2], vb, pa0, pa1, pa2, pa3); SBAR(); pv_one_lean<3>(o[3], vb, pa0, pa1, pa2, pa3);
}
constexpr int A_OFF_V = 0, A_OFF_K = 2 * 32768, A_OFF_WS = A_OFF_K + 2 * 16384, A_OFF_AUX = A_OFF_WS + NW * 64 * 4, A_LDS = A_OFF_AUX + 4096 * 4 + 256;
__device__ __forceinline__ void attn_unit_da(const AttnUnit& U, char* lds) {
  constexpr int DQK = 128, ND0 = 8, SHM_K = 16384, SHM_V2 = 32768;
  const int wid = __builtin_amdgcn_readfirstlane(U.wid), lane = mk_lane(), tid = wid * 64 + lane, r32 = lane & 31, hi = lane >> 5;
  char* K_lds = lds + A_OFF_K;
  float* ws = (float*)(lds + A_OFF_WS) + wid * 64; float* li_l = ws; float* al_l = ws + 32;
  float* aux = (float*)(lds + A_OFF_AUX); int* cls = (int*)(lds + A_OFF_AUX + 4096 * 4);
  const unsigned lds0 = (unsigned)(uintptr_t)lds;
  float m_reg = -1e30f, l_reg = 0; f32x16 o[8] = {}; bf16x8 qr[ND0];
  { const int qoff = (wid * QBLK + r32) * U.ldq + hi * 8;
#pragma unroll
    for (int d0 = 0; d0 < ND0; ++d0) qr[d0] = *reinterpret_cast<const bf16x8*>(U.Q + (qoff + d0 * 16)); }
  const int qrow = U.q0 + wid * QBLK + r32;
  const int pq0i = U.posg[U.q0];
  int pmin, pmax;
  { int a0 = U.posg[U.q0 + lane], a1 = U.posg[U.q0 + 64 + lane], a2 = U.posg[U.q0 + 128 + lane], a3 = U.posg[U.q0 + 192 + lane];
    int mnv = min(min(a0, a1), min(a2, a3)), mxv = max(max(a0, a1), max(a2, a3));
#pragma unroll
    for (int of = 1; of < 64; of <<= 1) { mnv = min(mnv, __shfl_xor(mnv, of)); mxv = max(mxv, __shfl_xor(mxv, of)); }
    pmin = __builtin_amdgcn_readfirstlane(mnv); pmax = __builtin_amdgcn_readfirstlane(mxv); }
  const float pq = (float)(U.posg[qrow] - pq0i);
  for (int i = tid; i < 4096; i += 512) { const int pk = U.posg[i]; const float rel = (float)(pk - pq0i) * U.nsl; aux[i] = (pk <= pmin && pk < pmax) ? -rel : ((pk >= pmax) ? rel : 0.f); }
#pragma unroll
  for (int k = 0; k < 8; ++k) { const int t = wid * 8 + k; int v = U.posg[t * 64 + lane], mnv = v, mxv = v;
#pragma unroll
    for (int of = 1; of < 64; of <<= 1) { mnv = min(mnv, __shfl_xor(mnv, of)); mxv = max(mxv, __shfl_xor(mxv, of)); }
    if (lane == 0) cls[t] = (mxv <= pmin && mxv < pmax) ? 0 : ((mnv >= pmax) ? 1 : 2); }
  const unsigned kdst = lds0 + A_OFF_K + wid * 1024, vdst = lds0 + A_OFF_V + wid * 1024;
  const int vb0 = (int)lds0 + A_OFF_V + v_rd_base(lane);
  const long kstep = (long)KVBLK * U.ldk, vstep = (long)KVBLK * U.ldv;
#define DMA_TILE(t, stg) do { const bf16_t* kp_ = U.K + (long)(t) * kstep; const bf16_t* vp_ = U.V + (long)(t) * vstep; const int tl_ = OPQ(tid) & 511;     \
    _Pragma("unroll") for (int i_ = 0; i_ < 2; ++i_) { const int L_ = i_ * 512 + tl_, row_ = L_ >> 4, c_ = (L_ & 15) ^ (row_ & 7); \
      glds16(kp_ + (row_ * U.ldk + c_ * 8), (unsigned)__builtin_amdgcn_readfirstlane(kdst + (stg) * SHM_K + i_ * 8192)); } \
    _Pragma("unroll") for (int i_ = 0; i_ < 2; ++i_) { const int L_ = i_ * 512 + tl_, blk_ = L_ >> 5, kk_ = (blk_ >> 2) * 8 + ((L_ & 31) >> 2), col_ = (blk_ & 3) * 32 + (L_ & 3) * 8; \
      const int k_ = (kk_ & ~0xC) | ((kk_ & 4) << 1) | ((kk_ & 8) >> 1); const bf16_t* vs_ = vp_ + (k_ * U.ldv + col_); \
      glds16(vs_, (unsigned)__builtin_amdgcn_readfirstlane(vdst + (stg) * SHM_V2 + i_ * 8192)); \
      glds16(vs_ + 128, (unsigned)__builtin_amdgcn_readfirstlane(vdst + (stg) * SHM_V2 + 16384 + i_ * 8192)); } } while (0)
#define WAIT_BAR_0() asm volatile("s_waitcnt vmcnt(0) lgkmcnt(0)\n\ts_barrier" ::: "memory")
  f32x16 p0, p1; float mn = 0.f, al = 1.f; bf16x8 pa0, pa1, pa2, pa3; const int NT = U.NT;
  DMA_TILE(0, 0);
  WAIT_BAR_0();
  for (int j = 0; j < NT; ++j) {
    const int st = j & 1;
    if (j + 1 < NT) DMA_TILE(j + 1, st ^ 1);
    float rc;
    { const int c_ = __builtin_amdgcn_readfirstlane(cls[j]); const float* ak_ = aux + j * KVBLK;
      if (c_ < 2) { rc = (c_ == 0) ? pq * U.nsl : -pq * U.nsl;
#pragma unroll
        for (int g = 0; g < 4; ++g) { const f32x4 a_ = *(const f32x4*)(ak_ + 8 * g + 4 * hi), b_ = *(const f32x4*)(ak_ + 32 + 8 * g + 4 * hi);
#pragma unroll
          for (int e = 0; e < 4; ++e) { p0[4 * g + e] = a_[e]; p1[4 * g + e] = b_[e]; } } }
      else { rc = 0.f; const int* pg_ = U.posg + j * KVBLK;
#pragma unroll
        for (int g = 0; g < 4; ++g)
#pragma unroll
          for (int e = 0; e < 4; ++e) { p0[4 * g + e] = fabsf(pq - (float)(pg_[8 * g + 4 * hi + e] - pq0i)) * U.nsl; p1[4 * g + e] = fabsf(pq - (float)(pg_[32 + 8 * g + 4 * hi + e] - pq0i)) * U.nsl; } } }
    SBAR(); qkt_acc<DQK>(p0, p1, K_lds + st * SHM_K, qr, r32, hi); SBAR();
    const float pmax = rowmax32(p0, p1) + rc;
    if (!__all((pmax - m_reg) * U.C < -150.f)) {
      partialSM_rc(p0, p1, m_reg, mn, al, U.C, U.thr, rc, pmax);
      if (__any(al < 1.f)) { if (hi == 0) al_l[r32] = al; asm volatile("s_waitcnt lgkmcnt(0)" ::: "memory");
#pragma unroll
        for (int d = 0; d < 8; ++d)
#pragma unroll
          for (int r = 0; r < 16; ++r) o[d][r] *= al_l[crow(r, hi)]; }
      finishSM(p0, p1, al, l_reg, pa0, pa1, pa2, pa3); SBAR();
      pv_d0_lean(o, vb0 + st * SHM_V2, pa0, pa1, pa2, pa3); SBAR();
      pv_d0_lean(o + 4, vb0 + st * SHM_V2 + 16384, pa0, pa1, pa2, pa3);
    }
    WAIT_BAR_0();
  }
  if (hi == 0) li_l[r32] = l_reg; asm volatile("s_waitcnt lgkmcnt(0)" ::: "memory");
  { const int le_ = OPQ(lane); const int obase = (wid * QBLK + 4 * (le_ >> 5)) * U.ldo + (le_ & 31);
#pragma unroll
    for (int r = 0; r < 16; ++r) { const int orl = (r & 3) + 8 * (r >> 2); const float rl = __builtin_amdgcn_rcpf(li_l[orl + 4 * hi]); const int ooff = obase + orl * U.ldo;
#pragma unroll
      for (int d0 = 0; d0 < 8; ++d0) U.O[ooff + d0 * 32] = (bf16_t)(cvtpk(o[d0][r] * rl, 0.f) & 0xffffu); } }
#undef DMA_TILE
#undef WAIT_BAR_0
}

template <int MODE>
__device__ __forceinline__ void attn_unit_ml(const AttnUnit& U, char* lds) {
  constexpr int DQK = 128, ND0 = 8, SHM_K = 16384, SHM_V2 = 32768;
  const int wid = __builtin_amdgcn_readfirstlane(U.wid), lane = mk_lane(), tid = wid * 64 + lane, r32 = lane & 31, hi = lane >> 5;
  char* K_lds = lds + A_OFF_K;
  float* ws = (float*)(lds + A_OFF_WS) + wid * 64; float* li_l = ws;
  float* aux = (float*)(lds + A_OFF_AUX);
  const unsigned lds0 = (unsigned)(uintptr_t)lds;
  float l_reg = 0; f32x16 o[8] = {}; bf16x8 qr[ND0];
  { const int qoff = (wid * QBLK + r32) * U.ldq + hi * 8;
#pragma unroll
    for (int d0 = 0; d0 < ND0; ++d0) qr[d0] = *reinterpret_cast<const bf16x8*>(U.Q + (qoff + d0 * 16)); }
  const int qrow = U.q0 + wid * QBLK + r32;
  const float Rr = U.Ag[U.q0] + U.lscale;
  for (int i = tid; i < 4096; i += 512) aux[i] = __builtin_amdgcn_exp2f(Rr - U.Bg[i]);
  const float At = U.Ag[qrow] + U.lscale, Et = U.Eg[qrow];
  const unsigned kdst = lds0 + A_OFF_K + wid * 1024, vdst = lds0 + A_OFF_V + wid * 1024;
  const int vb0 = (int)lds0 + A_OFF_V + v_rd_base(lane);
  const long kstep = (long)KVBLK * U.ldk, vstep = (long)KVBLK * U.ldv;
  const bf16_t* Kt = U.K + (long)U.jt0 * kstep; const bf16_t* Vt = U.V + (long)U.jt0 * vstep;
#define DMA_TILE(t, stg) do { const bf16_t* kp_ = Kt + (long)(t) * kstep; const bf16_t* vp_ = Vt + (long)(t) * vstep; const int tl_ = OPQ(tid) & 511; \
    _Pragma("unroll") for (int i_ = 0; i_ < 2; ++i_) { const int L_ = i_ * 512 + tl_, row_ = L_ >> 4, c_ = (L_ & 15) ^ (row_ & 7); \
      glds16(kp_ + (row_ * U.ldk + c_ * 8), (unsigned)__builtin_amdgcn_readfirstlane(kdst + (stg) * SHM_K + i_ * 8192)); } \
    _Pragma("unroll") for (int i_ = 0; i_ < 2; ++i_) { const int L_ = i_ * 512 + tl_, blk_ = L_ >> 5, kk_ = (blk_ >> 2) * 8 + ((L_ & 31) >> 2), col_ = (blk_ & 3) * 32 + (L_ & 3) * 8; \
      const int k_ = (kk_ & ~0xC) | ((kk_ & 4) << 1) | ((kk_ & 8) >> 1); const bf16_t* vs_ = vp_ + (k_ * U.ldv + col_); \
      glds16(vs_, (unsigned)__builtin_amdgcn_readfirstlane(vdst + (stg) * SHM_V2 + i_ * 8192)); \
      glds16(vs_ + 128, (unsigned)__builtin_amdgcn_readfirstlane(vdst + (stg) * SHM_V2 + 16384 + i_ * 8192)); } } while (0)
#define WAIT_BAR_0() asm volatile("s_waitcnt vmcnt(0) lgkmcnt(0)\n\ts_barrier" ::: "memory")
#define KB(j) ((U.jt0 + (j)) * KVBLK)
#define BAND(j) ((MODE == 2) ? (KB(j) + 63 > U.q0) : (KB(j) < U.q0 + 255))
  f32x16 p0, p1; bf16x8 pa0, pa1, pa2, pa3; const int NT = U.NT;
  DMA_TILE(0, 0);
  WAIT_BAR_0();
  for (int j = 0; j < NT; ++j) {
    const int st = j & 1;
    if (j + 1 < NT) DMA_TILE(j + 1, st ^ 1);
    p0 = f32x16{}; p1 = f32x16{};
    SBAR(); qkt_acc<DQK>(p0, p1, K_lds + st * SHM_K, qr, r32, hi); SBAR();
    partialW2<MODE>(p0, p1, aux + KB(j), BAND(j), qrow - KB(j) - 4 * hi, hi);
    finishW(p0, p1, l_reg, pa0, pa1, pa2, pa3); SBAR();
    pv_d0_lean(o, vb0 + st * SHM_V2, pa0, pa1, pa2, pa3); SBAR();
    pv_d0_lean(o + 4, vb0 + st * SHM_V2 + 16384, pa0, pa1, pa2, pa3);
    WAIT_BAR_0();
  }
  { const float rowf = __builtin_amdgcn_exp2f(At - Rr); const float lfin = fmaxf(fabsf(l_reg) * rowf, Et) * __builtin_amdgcn_rcpf(rowf);
    if (hi == 0) li_l[r32] = lfin; asm volatile("s_waitcnt lgkmcnt(0)" ::: "memory"); }
  { const int le_ = OPQ(lane); const int obase = (wid * QBLK + 4 * (le_ >> 5)) * U.ldo + (le_ & 31);
#pragma unroll
    for (int r = 0; r < 16; ++r) { const int orl = (r & 3) + 8 * (r >> 2); const float rl = __builtin_amdgcn_rcpf(li_l[orl + 4 * hi]); const int ooff = obase + orl * U.ldo;
#pragma unroll
      for (int d0 = 0; d0 < 8; ++d0) U.O[ooff + d0 * 32] = (bf16_t)(cvtpk(o[d0][r] * rl, 0.f) & 0xffffu); } }
#undef DMA_TILE
#undef WAIT_BAR_0
#undef KB
#undef BAND
}
}

#define LAS __attribute__((address_space(3)))
typedef unsigned short bf16_t;
typedef float f32x4 __attribute__((ext_vector_type(4)));
typedef unsigned u32x4 __attribute__((ext_vector_type(4)));
typedef short bf16x8 __attribute__((ext_vector_type(8)));
constexpr int BATCH = 8, SEQ = 4096, T = BATCH * SEQ, DM = 2048, FF = 5632;
constexpr int NPH = 19;
constexpr int LDS_BYTES = 147456;
constexpr float LAM_INIT = 0.35550906759096934f;
constexpr float LOG2E = 1.4426950408889634f;
constexpr size_t MiB = 1u << 20;
constexpr size_t WS_SS = 1009 * MiB, WS_CS = 2 * MiB, WS_MG = 10 * MiB, WS_GA = 12 * MiB, WS_GB = 13 * MiB, WS_GE = 14 * MiB;
constexpr size_t WS_BAR = 15 * MiB, WS_BAR_BYTES = 16384;
constexpr size_t WS_WIN0 = 16 * MiB, WS_WUQ = WS_WIN0 + 17 * MiB, WS_WUKV = WS_WUQ + 2 * MiB, WS_WO0 = WS_WUKV + 2 * MiB, WS_WIN1 = WS_WO0 + 8 * MiB, WS_WO1 = WS_WIN1 + 24 * MiB;
constexpr size_t WS_WGU1 = 77 * MiB, WS_WDN1 = WS_WGU1 + 44 * MiB, WS_XB = 143 * MiB, WS_A = 271 * MiB, WS_B = 655 * MiB, WS_WGU2 = 943 * MiB, WS_WDN2 = WS_WGU2 + 44 * MiB, WS_END = 1012 * MiB;
static_assert(WS_WO1 + 8 * MiB <= WS_WGU1 && WS_WDN1 + 22 * MiB <= WS_XB, "ws map");
__constant__ double INV_FREQ[32] = {1.0, 0.7498942093324559, 0.5623413251903491, 0.4216965034285822, 0.31622776601683794, 0.23713737056616552, 0.1778279410038923, 0.1333521432163324,
    0.1, 0.07498942093324558, 0.05623413251903491, 0.042169650342858224, 0.03162277660168379, 0.023713737056616554, 0.01778279410038923, 0.01333521432163324,
    0.01, 0.007498942093324558, 0.005623413251903491, 0.004216965034285823, 0.0031622776601683794, 0.0023713737056616554, 0.0017782794100389228, 0.001333521432163324,
    0.001, 0.0007498942093324559, 0.0005623413251903491, 0.00042169650342858224, 0.00031622776601683794, 0.00023713737056616554, 0.00017782794100389227, 0.0001333521432163324};

#define XB_TMO      128
#define XB_XCNT(j)  (256  + 64 * (j))
#define XB_XSUB(j)  (1280 + 64 * (j))
#define XB_XGEN(j)  (2304 + 64 * (j))
#define XB_TOP      3328
#define XB_TOPGEN   3392
#define XCD_BAR_WORDS 3456
#define XB_SPIN_CAP (1u << 18)

__device__ __forceinline__ unsigned xb_ld(unsigned* p)              { return __hip_atomic_load(p, __ATOMIC_RELAXED, __HIP_MEMORY_SCOPE_AGENT); }
__device__ __forceinline__ unsigned xb_add(unsigned* p, unsigned v) { return __hip_atomic_fetch_add(p, v, __ATOMIC_RELAXED, __HIP_MEMORY_SCOPE_AGENT); }
__device__ __forceinline__ unsigned xb_xcc_id() { return (unsigned)__builtin_amdgcn_s_getreg((3 << 11) | 20) & 0xFu; }
#define XB_SPIN(cond, bar) do { unsigned _sp = 0; while (cond) { __builtin_amdgcn_s_sleep(1); \
    if ((++_sp & 255u) == 0u) { if (xb_ld(&(bar)[XB_TMO])) break; if (_sp > XB_SPIN_CAP) { atomicAdd(&(bar)[XB_TMO], 1u); break; } } } } while (0)

struct XcdBarrier {
    unsigned* bar; unsigned x; unsigned w;
    volatile LAS unsigned* st;
};

__device__ __forceinline__ XcdBarrier xcd_barrier_post(unsigned* bar, volatile LAS unsigned* st, unsigned wave) {
    XcdBarrier b; b.bar = bar; b.x = xb_xcc_id(); b.st = st; b.w = wave;
    if (wave == 0u && mk_lane() == 0) (void)xb_add(&bar[XB_XCNT(b.x)], 1u);
    return b;
}
__device__ __forceinline__ void xcd_barrier_complete(unsigned* bar, unsigned x, unsigned& nloc, unsigned& nx) {
    const unsigned G = gridDim.x * gridDim.y * gridDim.z;
    unsigned sum, cnt, mine, sp = 0u;
    for (;;) {
        sum = 0u; cnt = 0u; mine = 0u;
#pragma unroll
        for (unsigned j = 0; j < 16; ++j) { const unsigned c = xb_ld(&bar[XB_XCNT(j)]); sum += c; cnt += (c > 0u) ? 1u : 0u; mine = (j == x) ? c : mine; }
        if (sum == G) break;
        __builtin_amdgcn_s_sleep(1);
        if ((++sp & 255u) == 0u) { if (xb_ld(&bar[XB_TMO])) break; if (sp > XB_SPIN_CAP) { atomicAdd(&bar[XB_TMO], 1u); break; } }
    }
    nloc = mine > 0u ? mine : 1u; nx = cnt > 0u ? cnt : 1u;
}

__device__ __forceinline__ void xcd_barrier(const XcdBarrier& b) {
    asm volatile("s_waitcnt vmcnt(0)" ::: "memory");
    __syncthreads();
    if (b.w == 0u && mk_lane() == 0) {
        unsigned* bar = b.bar;
        __builtin_amdgcn_s_waitcnt(0);
        unsigned nloc = b.st[0], nx = b.st[1];
        if (nloc == 0u) { xcd_barrier_complete(bar, b.x, nloc, nx); b.st[0] = nloc; b.st[1] = nx; }
        const unsigned old = xb_add(&bar[XB_XSUB(b.x)], 1u);
        const unsigned gen = old / nloc;
        if (old + 1u == (gen + 1u) * nloc) {
            __builtin_amdgcn_fence(__ATOMIC_RELEASE, "agent");
            asm volatile("s_waitcnt vmcnt(0)" ::: "memory");
            const unsigned og = xb_add(&bar[XB_TOP], 1u);
            const unsigned tg = og / nx;
            if (og + 1u == (tg + 1u) * nx) xb_add(&bar[XB_TOPGEN], 1u);
            else XB_SPIN(xb_ld(&bar[XB_TOPGEN]) == tg, bar);
            __builtin_amdgcn_fence(__ATOMIC_ACQUIRE, "agent");
            xb_add(&bar[XB_XGEN(b.x)], 1u);
            asm volatile("s_waitcnt vmcnt(0)" ::: "memory");
        } else {
            XB_SPIN(xb_ld(&bar[XB_XGEN(b.x)]) == gen, bar);
            __builtin_amdgcn_fence(__ATOMIC_ACQUIRE, "agent");
            asm volatile("s_waitcnt vmcnt(0)" ::: "memory");
        }
    }
    __syncthreads();
}

__device__ __forceinline__ float wave_sum(float v) {
#pragma unroll
    for (int o = 1; o < 64; o <<= 1) v += __shfl_xor(v, o);
    return v;
}
__device__ __forceinline__ float bf2f(short b) { return __uint_as_float(((unsigned)(unsigned short)b) << 16); }
__device__ __forceinline__ unsigned pk2(float lo, float hi) { return pg8::cvt_pk_bf16(lo, hi); }

enum { MAP_ID = 0, MAP_GU = 1, MAP_IN0 = 2, MAP_UQ = 3 };
__device__ __forceinline__ int map_row(int type, int n) {
    if (type == MAP_GU) { if (n < FF) return (n >> 7) * 256 + (n & 127); const int q = n - FF; return (q >> 7) * 256 + 128 + (q & 127); }
    if (type == MAP_IN0) { if (n < 1024) return n; if (n < 1056) return 4096 + (n - 1024); if (n < 1088) return 4096 + 128 + (n - 1056); if (n < 4160) return n - 64; return 4096 + 32 + (n - 4160); }
    if (type == MAP_UQ) { const int h = n / 192, r = n - h * 192; if (r < 128) return h * 128 + r; if (r < 160) return 1024 + 256 * (h >> 2) + (h & 3) * 32 + (r - 128); return 1024 + 256 * (h >> 2) + 128 + (h & 3) * 32 + (r - 160); }
    return n;
}
__device__ __forceinline__ void convert_matrix(const float* W, const float* g, int K, int N, bf16_t* WT, int type, int gw, int NGW, LAS float* scr, int lane) {
    const int nblk = (N + 31) >> 5, nitems = (K >> 6) * nblk;
    const int c4 = (lane & 7) * 4, kr = lane >> 3, c8 = lane & 7;
    f32x4 cur[8], nxt[8];
#define CM_LOAD(dst, it_) do { const int kb_ = (it_) / nblk, nb_ = (it_) - kb_ * nblk, k0_ = kb_ << 6, n0_ = nb_ << 5; const bool ok_ = (it_) < nitems && (n0_ + c4) < N; \
        _Pragma("unroll") for (int i_ = 0; i_ < 8; ++i_) { const int kk_ = kr + 8 * i_; f32x4 v_ = {0.f, 0.f, 0.f, 0.f}; \
            if (ok_) { v_ = *(const f32x4*)(W + (size_t)(k0_ + kk_) * N + n0_ + c4); if (g) v_ = v_ * g[k0_ + kk_]; } dst[i_] = v_; } } while (0)
    int item = gw;
    CM_LOAD(cur, item);
    for (; item < nitems; item += NGW) {
        CM_LOAD(nxt, item + NGW);
        const int kb = item / nblk, nb = item - kb * nblk, k0 = kb << 6, n0 = nb << 5, ncols = (N - n0) < 32 ? (N - n0) : 32;
#pragma unroll
        for (int i = 0; i < 8; ++i) { LAS float* d = scr + (kr + 8 * i) * 33 + c4; d[0] = cur[i].x; d[1] = cur[i].y; d[2] = cur[i].z; d[3] = cur[i].w; }
        asm volatile("s_waitcnt lgkmcnt(0)" ::: "memory");
        const int drow0 = map_row(type, n0);
#pragma unroll
        for (int j = 0; j < 4; ++j) { const int n = kr + 8 * j; const LAS float* s = scr + (8 * c8) * 33 + n;
            u32x4 o; o.x = pk2(s[0 * 33], s[1 * 33]); o.y = pk2(s[2 * 33], s[3 * 33]); o.z = pk2(s[4 * 33], s[5 * 33]); o.w = pk2(s[6 * 33], s[7 * 33]);
            if (n < ncols) *(u32x4*)(WT + (size_t)(drow0 + n) * K + k0 + 8 * c8) = o; }
        asm volatile("s_waitcnt lgkmcnt(0)" ::: "memory");
#pragma unroll
        for (int i = 0; i < 8; ++i) cur[i] = nxt[i];
    }
#undef CM_LOAD
}
__device__ __forceinline__ float logsig(float x) { return fminf(x, 0.f) - log1pf(expf(-fabsf(x))); }

struct Params { const float* in[32]; float* out; unsigned char* ws; int ph_lo, ph_hi; };

__global__ void __launch_bounds__(512, 2) fwd_kernel(Params p) {
    extern __shared__ __attribute__((aligned(16))) unsigned char lds[];
    const int wave = __builtin_amdgcn_readfirstlane((int)threadIdx.x >> 6); const int tid = wave * 64 + mk_lane();
#define lane mk_lane()
    const int G = gridDim.x, bx = blockIdx.x, vcu = (G % 8 == 0) ? (bx % 8) * (G / 8) + bx / 8 : bx;
    const int gw = vcu * 8 + wave, NGW = G * 8;
    const long gtid = (long)vcu * 512 + tid, NGT = (long)G * 512;
    unsigned char* ws = p.ws;
    pg8::ssq_t* SS = (pg8::ssq_t*)(ws + WS_SS);
    float* CS = (float*)(ws + WS_CS); float* MG = (float*)(ws + WS_MG);
    float* GA = (float*)(ws + WS_GA); float* GB = (float*)(ws + WS_GB); float* GE = (float*)(ws + WS_GE);
    bf16_t* W_IN0 = (bf16_t*)(ws + WS_WIN0); bf16_t* W_UQ = (bf16_t*)(ws + WS_WUQ); bf16_t* W_UKV = (bf16_t*)(ws + WS_WUKV); bf16_t* W_O0 = (bf16_t*)(ws + WS_WO0);
    bf16_t* W_IN1 = (bf16_t*)(ws + WS_WIN1); bf16_t* W_O1 = (bf16_t*)(ws + WS_WO1);
    bf16_t* W_GU1 = (bf16_t*)(ws + WS_WGU1); bf16_t* W_DN1 = (bf16_t*)(ws + WS_WDN1); bf16_t* W_GU2 = (bf16_t*)(ws + WS_WGU2); bf16_t* W_DN2 = (bf16_t*)(ws + WS_WDN2);
    bf16_t* XB = (bf16_t*)(ws + WS_XB); bf16_t* HFB = XB;
    bf16_t* RA = (bf16_t*)(ws + WS_A); bf16_t* RB = (bf16_t*)(ws + WS_B);
    bf16_t* Hh = RA;
    bf16_t* Z0 = RA; bf16_t* Qm = RA + (size_t)T * 4096;
    bf16_t* KF = RB; bf16_t* Vm = RB + (size_t)T * 1536; bf16_t* AO = Vm + (size_t)T * 1024;
    bf16_t* QKV1 = RA; bf16_t* O12 = RB; bf16_t* COMB = RA;
    LAS unsigned char* ldsl = (LAS unsigned char*)lds;
    LAS float* scr = (LAS float*)(ldsl + wave * 16384);
#ifndef PHMASK
#define PHMASK 0xFFFFFFu
#endif
#define IN(k) ((((PHMASK) >> (k)) & 1u) && p.ph_lo <= (k) && (k) < p.ph_hi)
#ifndef REPMASK
#define REPMASK 0u
#endif
#define REP(k) for (int rep_ = 0; rep_ <= (int)(((REPMASK) >> (k)) & 1u); ++rep_)
#if MK_N_LAUNCHES == 1
#define SEAM0() do { cg::this_grid().sync(); } while (0)
#define SEAM() do { xcd_barrier(xbar); } while (0)
#else
#define SEAM0() do { } while (0)
#define SEAM() do { } while (0)
#endif
#define FFN_UP(WGU, ssi) do { pg8::Gemm g_{XB, WGU, T, 2 * FF, DM, DM}; pg8::StaticOrder S_; S_.init(T, 2 * FF, G, bx); pg8::EpiSwiglu E_{Hh, SS + (size_t)(ssi) * T}; \
        pg8::gemm_phase<pg8::EpiSwiglu, pg8::StaticOrder, true, true>(ldsl, g_, S_, E_, wave); } while (0)
#define GEMM_RESID(Aop, Kdim, WT, XIN, ssi, ALPHA) do { pg8::Gemm g_{Aop, WT, T, DM, Kdim, Kdim}; pg8::StaticOrder S_; S_.init(T, DM, G, bx); pg8::EpiResid E_{XIN, p.out, XB, SS + (size_t)(ssi) * T, ALPHA}; \
        pg8::gemm_phase<pg8::EpiResid, pg8::StaticOrder, true, true>(ldsl, g_, S_, E_, wave); } while (0)
#define CONVERT_FFN(igu, WGU, WDN) do { convert_matrix(p.in[(igu) + 1], p.in[igu], DM, 2 * FF, WGU, MAP_GU, gw, NGW, scr, lane); convert_matrix(p.in[(igu) + 2], nullptr, FF, DM, WDN, MAP_ID, gw, NGW, scr, lane); } while (0)

#if MK_N_LAUNCHES == 1
    if (tid < 2) ((LAS unsigned*)(ldsl + LDS_BYTES - 64))[tid] = 0u;
    __syncthreads();
    XcdBarrier xbar = xcd_barrier_post((unsigned*)(ws + WS_BAR), (volatile LAS unsigned*)(ldsl + LDS_BYTES - 64), (unsigned)wave);
#endif
    if (IN(0)) REP(0) {
        for (long i = gtid; i < 8L * T; i += NGT) SS[T + i] = 0ull;
        { const float* x = p.in[0];
          for (int row = gw; row < T; row += NGW) { const f32x4* xr = (const f32x4*)(x + (size_t)row * DM) + lane; float s = 0.f; unsigned long long* o8 = (unsigned long long*)(XB + (size_t)row * DM) + lane;
#pragma unroll
            for (int j = 0; j < 8; ++j) { const f32x4 v = xr[64 * j]; s += (v.x * v.x + v.y * v.y) + (v.z * v.z + v.w * v.w); o8[64 * j] = (unsigned long long)pk2(v.x, v.y) | ((unsigned long long)pk2(v.z, v.w) << 32); }
            s = wave_sum(s); if (lane == 0) SS[row] = (pg8::ssq_t)(s * 16777216.0f); } }
        { const int* pos = (const int*)p.in[1];
          for (long i = gtid; i < 32L * T; i += NGT) { const int t = (int)(i >> 5), k = (int)(i & 31); const double rev = (double)pos[t] * INV_FREQ[k] * 0.15915494309189535; const float fr = (float)(rev - rint(rev));
            CS[(size_t)t * 64 + k] = __builtin_amdgcn_cosf(fr); CS[(size_t)t * 64 + 32 + k] = __builtin_amdgcn_sinf(fr); } }
        for (long i = gtid; i < 176L * 256; i += NGT) { const int r = (int)(i >> 8), c = (int)(i & 255); const int row = 4096 + (r < 80 ? 48 + r : 160 + (r - 80)); *(u32x4*)(W_IN0 + (size_t)row * DM + c * 8) = (u32x4){0u, 0u, 0u, 0u}; }
        convert_matrix(p.in[6], p.in[5], DM, 4176, W_IN0, MAP_IN0, gw, NGW, scr, lane);
        convert_matrix(p.in[8], p.in[7], 512, 1536, W_UQ, MAP_UQ, gw, NGW, scr, lane);
        convert_matrix(p.in[10], p.in[9], 512, 2048, W_UKV, MAP_ID, gw, NGW, scr, lane);
        convert_matrix(p.in[13], nullptr, DM, DM, W_O0, MAP_ID, gw, NGW, scr, lane);
        convert_matrix(p.in[21], p.in[20], DM, 6144, W_IN1, MAP_ID, gw, NGW, scr, lane);
        convert_matrix(p.in[27], nullptr, DM, DM, W_O1, MAP_ID, gw, NGW, scr, lane);
        CONVERT_FFN(2, W_GU1, W_DN1);
    }
    SEAM0();
    if (IN(1)) REP(1) FFN_UP(W_GU1, 0);
    SEAM();
    if (IN(2)) GEMM_RESID(Hh, FF, W_DN1, p.in[0], 1, 0.5f);
    SEAM();
    if (IN(3)) { pg8::Gemm g_{XB, W_IN0, T, 4352, DM, DM}; pg8::StaticOrder S_; S_.init(T, 4352, G, bx);
        pg8::EpiIn0 E_{Z0, KF, MG, SS + (size_t)1 * T, SS + (size_t)7 * T, SS + (size_t)8 * T, CS, p.in[11]};
        pg8::gemm_phase<pg8::EpiIn0, pg8::StaticOrder, true, true>(ldsl, g_, S_, E_, wave); }
    SEAM();
    if (IN(4)) REP(4) {
        { pg8::Gemm g_{Z0, W_UQ, T, 1536, 512, 4096}; pg8::StaticOrder S_; S_.init(T, 1536, G, bx); pg8::EpiUq E_{Qm, SS + (size_t)7 * T, CS};
          pg8::gemm_phase<pg8::EpiUq, pg8::StaticOrder, true, true>(ldsl, g_, S_, E_, wave); }
        { pg8::Gemm g_{Z0 + 512, W_UKV, T, 2048, 512, 4096}; pg8::StaticOrder S_; S_.init(T, 2048, G, bx); pg8::EpiUkv E_{KF, Vm, SS + (size_t)8 * T};
          pg8::gemm_phase<pg8::EpiUkv, pg8::StaticOrder, true, true>(ldsl, g_, S_, E_, wave); }
        if ((gw & 31) == 0) for (int c = gw >> 5; c < 64; c += (NGW >> 5)) {
            const int dir = c >> 5, bh = c & 31, b = bh >> 2, h = bh & 3; const float* mg = MG + (size_t)b * SEQ * 16; const int ci = (dir ? 8 : 0) + h, cf = (dir ? 12 : 4) + h;
            float Fseg = 0.f, Mseg = -INFINITY;
            for (int u0 = 0; u0 < 64; u0 += 16) { float li[16], gf[16];
#pragma unroll
                for (int u = 0; u < 16; ++u) { const int up = lane * 64 + u0 + u, t = dir ? (SEQ - 1 - up) : up; li[u] = mg[t * 16 + ci]; gf[u] = mg[t * 16 + cf]; }
#pragma unroll
                for (int u = 0; u < 16; ++u) { const float lf = logsig(gf[u]); Fseg += lf; Mseg = fmaxf(Mseg + lf, li[u]); } }
            float runF = 0.f, runM = -1e30f, myF = 0.f, myM = 0.f;
            for (int i = 0; i < 64; ++i) { const float Fi = __shfl(Fseg, i), Mi = __shfl(Mseg, i); if (lane == i) { myF = runF; myM = runM; } runF += Fi; runM = fmaxf(runM + Fi, Mi); }
            float F = myF, m = myM; float* ga = GA + (size_t)c * SEQ; float* gb = GB + (size_t)c * SEQ; float* ge = GE + (size_t)c * SEQ;
            for (int u0 = 0; u0 < 64; u0 += 16) { float li[16], gf[16];
#pragma unroll
                for (int u = 0; u < 16; ++u) { const int up = lane * 64 + u0 + u, t = dir ? (SEQ - 1 - up) : up; li[u] = mg[t * 16 + ci]; gf[u] = mg[t * 16 + cf]; }
#pragma unroll
                for (int u = 0; u < 16; ++u) { const int up = lane * 64 + u0 + u, t = dir ? (SEQ - 1 - up) : up; const float lf = logsig(gf[u]); F += lf; m = fmaxf(m + lf, li[u]);
                    ga[t] = (F - m) * LOG2E; gb[t] = (F - li[u]) * LOG2E; ge[t] = expf(-m); } }
        }
        CONVERT_FFN(14, W_GU1, W_DN1);
    }
    SEAM();
    if (IN(5)) REP(5) {
#ifndef P5SEL
#define P5SEL 3
#endif
        if (P5SEL & 1) for (int it = vcu; it < 1024; it += G) {
            att::AttnUnit U{};
            const int qb = it & 15, bh = it >> 4, b = bh >> 3, h = bh & 7; const size_t r0 = (size_t)b * SEQ;
            U.Q = Qm + (r0 + qb * 256) * 1536 + h * 192; U.K = KF + r0 * 1536 + h * 192; U.V = Vm + r0 * 1024 + h * 128; U.O = AO + (r0 + qb * 256) * 2048 + h * 128;
            U.ldq = 1536; U.ldk = 1536; U.ldv = 1024; U.ldo = 2048; U.jt0 = 0; U.NT = 64; U.q0 = qb * 256;
            U.C = 0.07216878364870322f * LOG2E; U.thr = 8.0f / 0.07216878364870322f;
            U.wid = wave; att::attn_unit_dma<192, 0>(U, (char*)lds);
        }
        if (P5SEL & 2) for (int i2 = vcu; i2 < 1024; i2 += G) {
            att::AttnUnit U{};
            const int dir = i2 >> 9, i3 = i2 & 511, qb = i3 & 15, bh = i3 >> 4, b = bh >> 2, h = bh & 3; const size_t r0 = (size_t)b * SEQ;
            U.Q = Z0 + (r0 + qb * 256) * 4096 + 1024 + h * 128; U.K = Z0 + r0 * 4096 + 1536 + h * 128; U.V = Z0 + r0 * 4096 + 2048 + h * 256;
            U.ldq = 4096; U.ldk = 4096; U.ldv = 4096; U.ldo = 1024; U.q0 = qb * 256; U.lscale = -3.5f;
            const int ch = dir * 32 + bh;
            U.Ag = GA + (size_t)ch * SEQ; U.Bg = GB + (size_t)ch * SEQ; U.Eg = GE + (size_t)ch * SEQ;
            U.O = HFB + (size_t)dir * T * 1024 + (r0 + qb * 256) * 1024 + h * 256;
            U.wid = wave; if (dir == 0) { U.jt0 = 0; U.NT = 4 * (qb + 1); att::attn_unit_ml<2>(U, (char*)lds); }
            else { U.jt0 = 4 * qb; U.NT = 64 - 4 * qb; att::attn_unit_ml<3>(U, (char*)lds); }
        }
    }
    SEAM();
    if (IN(6)) {
        const float* gm = p.in[12];
        for (int row = gw; row < T; row += NGW) {
            const bf16x8* hf = (const bf16x8*)(HFB + (size_t)row * 1024 + lane * 16); const bf16x8* hb = (const bf16x8*)(HFB + (size_t)T * 1024 + (size_t)row * 1024 + lane * 16);
            const bf16x8* mo = (const bf16x8*)(Z0 + (size_t)row * 4096 + 3072 + lane * 16);
            float hm[16]; float sq = 0.f;
#pragma unroll
            for (int j = 0; j < 2; ++j) { const bf16x8 a = hf[j], b = hb[j];
#pragma unroll
                for (int e = 0; e < 8; ++e) { const float v = bf2f(a[e]) + bf2f(b[e]); hm[8 * j + e] = v; sq += v * v; } }
            sq += __shfl_xor(sq, 1); sq += __shfl_xor(sq, 2); sq += __shfl_xor(sq, 4); sq += __shfl_xor(sq, 8);
            const float rs = __builtin_amdgcn_rsqf(sq * (1.0f / 256.0f) + 1e-6f);
#pragma unroll
            for (int j = 0; j < 2; ++j) { const bf16x8 mv = mo[j]; const f32x4 g0 = *(const f32x4*)(gm + lane * 16 + 8 * j), g1 = *(const f32x4*)(gm + lane * 16 + 8 * j + 4); float y[8];
#pragma unroll
                for (int e = 0; e < 8; ++e) { const float gg = e < 4 ? g0[e] : g1[e - 4]; const float sg = __builtin_amdgcn_rcpf(1.0f + __builtin_amdgcn_exp2f(-LOG2E * bf2f(mv[e]))); y[e] = hm[8 * j + e] * rs * gg * sg; }
                u32x4 w; w.x = pk2(y[0], y[1]); w.y = pk2(y[2], y[3]); w.z = pk2(y[4], y[5]); w.w = pk2(y[6], y[7]);
                *(u32x4*)(AO + (size_t)row * 2048 + 1024 + lane * 16 + 8 * j) = w; }
        }
        CONVERT_FFN(17, W_GU2, W_DN2);
    }
    SEAM();
    if (IN(7)) GEMM_RESID(AO, DM, W_O0, p.out, 2, 1.0f);
    SEAM();
    if (IN(8)) FFN_UP(W_GU1, 2);
    SEAM();
    if (IN(9)) GEMM_RESID(Hh, FF, W_DN1, p.out, 3, 0.5f);
    SEAM();
    if (IN(10)) FFN_UP(W_GU2, 3);
    SEAM();
    if (IN(11)) GEMM_RESID(Hh, FF, W_DN2, p.out, 4, 0.5f);
    SEAM();
    if (IN(12)) { { pg8::Gemm g_{XB, W_IN1, T, 6144, DM, DM}; pg8::StaticOrder S_; S_.init(T, 6144, G, bx); pg8::EpiScaled E_{QKV1, 6144, SS + (size_t)4 * T, 1.0f / 2048.0f};
          pg8::gemm_phase<pg8::EpiScaled, pg8::StaticOrder, true, true>(ldsl, g_, S_, E_, wave); }
        CONVERT_FFN(28, W_GU1, W_DN1); }
    SEAM();
    if (IN(13)) REP(13) {
        const int* pos = (const int*)p.in[1];
        for (int it = vcu; it < 2048; it += G) {
            const int q_ = it & 15, mp = (it >> 4) & 1, b = (it >> 5) & 7, h = it >> 8, qb = (q_ + ((h < 4) ? ((0x084C >> (4 * h)) & 15) : 0)) & 15; const size_t r0 = (size_t)b * SEQ;
            att::AttnUnit U{};
            U.Q = QKV1 + (r0 + qb * 256) * 6144 + h * 256 + mp * 128; U.K = QKV1 + r0 * 6144 + 2048 + h * 256 + mp * 128; U.V = QKV1 + r0 * 6144 + 4096 + h * 256;
            U.O = O12 + (r0 + qb * 256) * 4096 + h * 512 + mp * 256;
            U.ldq = 6144; U.ldk = 6144; U.ldv = 6144; U.ldo = 4096; U.jt0 = 0; U.NT = 64; U.q0 = qb * 256;
            U.C = 0.08838834764831845f * LOG2E; U.thr = 8.0f / 0.08838834764831845f; U.posg = pos + r0; U.nsl = -exp2f(-(float)(h + 1)) * 11.313708498984761f;
            U.wid = wave; att::attn_unit_da(U, (char*)lds);
        }
    }
    SEAM();
    if (IN(14)) {
        float l1 = p.in[22][lane] * p.in[23][lane] + p.in[22][lane + 64] * p.in[23][lane + 64], l2 = p.in[24][lane] * p.in[25][lane] + p.in[24][lane + 64] * p.in[25][lane + 64];
        l1 = wave_sum(l1); l2 = wave_sum(l2); const float lam = expf(l1) - expf(l2) + LAM_INIT;
        const float* gs = p.in[26]; const int head = lane >> 3, e0 = (lane & 7) * 32;
        for (int row = gw; row < T; row += NGW) {
            const bf16x8* o1 = (const bf16x8*)(O12 + (size_t)row * 4096 + head * 512 + e0); const bf16x8* o2 = (const bf16x8*)(O12 + (size_t)row * 4096 + head * 512 + 256 + e0);
            float d[32]; float sq = 0.f;
#pragma unroll
            for (int j = 0; j < 4; ++j) { const bf16x8 a = o1[j], b = o2[j];
#pragma unroll
                for (int e = 0; e < 8; ++e) { const float v = bf2f(a[e]) - lam * bf2f(b[e]); d[8 * j + e] = v; sq += v * v; } }
            sq += __shfl_xor(sq, 1); sq += __shfl_xor(sq, 2); sq += __shfl_xor(sq, 4);
            const float rs = __builtin_amdgcn_rsqf(sq * (1.0f / 256.0f) + 1e-6f) * (1.0f - LAM_INIT);
#pragma unroll
            for (int j = 0; j < 4; ++j) { const f32x4 g0 = *(const f32x4*)(gs + e0 + 8 * j), g1 = *(const f32x4*)(gs + e0 + 8 * j + 4); u32x4 w;
                w.x = pk2(d[8 * j + 0] * rs * g0[0], d[8 * j + 1] * rs * g0[1]); w.y = pk2(d[8 * j + 2] * rs * g0[2], d[8 * j + 3] * rs * g0[3]);
                w.z = pk2(d[8 * j + 4] * rs * g1[0], d[8 * j + 5] * rs * g1[1]); w.w = pk2(d[8 * j + 6] * rs * g1[2], d[8 * j + 7] * rs * g1[3]);
                *(u32x4*)(COMB + (size_t)row * 2048 + head * 256 + e0 + 8 * j) = w; }
        }
    }
    SEAM();
    if (IN(15)) GEMM_RESID(COMB, DM, W_O1, p.out, 5, 1.0f);
    SEAM();
    if (IN(16)) FFN_UP(W_GU1, 5);
    SEAM();
    if (IN(17)) { pg8::Gemm g_{Hh, W_DN1, T, DM, FF, FF}; pg8::StaticOrder S_; S_.init(T, DM, G, bx); pg8::EpiResidT<false> E_{p.out, p.out, XB, SS + (size_t)6 * T, 0.5f};
        pg8::gemm_phase<pg8::EpiResidT<false>, pg8::StaticOrder, true, true>(ldsl, g_, S_, E_, wave); }
    SEAM();
    if (IN(18)) { const float* gf = p.in[31];
        for (int row = gw; row < T; row += NGW) { f32x4* xr = (f32x4*)(p.out + (size_t)row * DM) + lane; const float rs = pg8::rstd_of(SS[(size_t)6 * T + row], 1.0f / 2048.0f);
#pragma unroll
            for (int j = 0; j < 8; ++j) { const f32x4 g = ((const f32x4*)gf)[64 * j + lane]; xr[64 * j] = xr[64 * j] * rs * g; } } }
#undef IN
#undef lane
}

extern "C" void kernel_launch(void* const* d_in, const int* in_sizes, int n_in, void* d_out, int out_size, void* d_ws, size_t ws_size, hipStream_t stream) {
    static int grid = 0;
    if (grid == 0) {
        if (n_in != 32 || out_size != T * DM || ws_size < WS_END) { fprintf(stderr, "kernel_launch: unexpected shapes: n_in %d out %d ws %zu (need >= %zu)\n", n_in, out_size, ws_size, (size_t)WS_END); grid = -1; return; }
        int dev = 0, cus = 0, per_cu = 0;
        hipGetDevice(&dev); hipDeviceGetAttribute(&cus, hipDeviceAttributeMultiprocessorCount, dev);
        if (hipFuncSetAttribute((const void*)fwd_kernel, hipFuncAttributeMaxDynamicSharedMemorySize, LDS_BYTES) != hipSuccess) { fprintf(stderr, "kernel_launch: hipFuncSetAttribute failed\n"); grid = -1; return; }
        if (hipOccupancyMaxActiveBlocksPerMultiprocessor(&per_cu, (const void*)fwd_kernel, 512, LDS_BYTES) != hipSuccess || per_cu < 1) { fprintf(stderr, "kernel_launch: occupancy query says %d\n", per_cu); per_cu = 1; }
        (void)hipGetLastError();
        grid = cus * 1;
    }
    if (grid < 0) return;
    Params a{};
    for (int i = 0; i < 32; ++i) a.in[i] = (const float*)d_in[i];
    a.out = (float*)d_out; a.ws = (unsigned char*)d_ws;
#if MK_N_LAUNCHES == 1
    a.ph_lo = 0; a.ph_hi = NPH;
    if (hipMemsetAsync((char*)d_ws + WS_BAR, 0, WS_BAR_BYTES, stream) != hipSuccess) { fprintf(stderr, "kernel_launch: memset of barrier words failed\n"); return; }
    void* args[] = {&a};
    hipError_t e = hipLaunchCooperativeKernel((const void*)fwd_kernel, dim3(grid), dim3(512), args, LDS_BYTES, stream);
    if (e != hipSuccess) fprintf(stderr, "kernel_launch: cooperative launch failed: %s (grid %d)\n", hipGetErrorString(e), grid);
#else
    for (int k = 0; k < NPH; ++k) { a.ph_lo = k; a.ph_hi = k + 1; hipLaunchKernelGGL(fwd_kernel, dim3(grid), dim3(512), LDS_BYTES, stream, a); }
#endif
}
```
